# Optimizing an MI355X kernel written in HIP

```python
import jax, jax.numpy as jnp
from jax import lax
import numpy as np

D_MODEL = 1024
BATCH = 8
SEQ = 2048
DEPTH = 1
DEC_BATCH = 128
DEC_SEQ = 4
PAST_LEN = 16384
PAGE_SIZE = 128

HEAD_DIM = 64
N_HEADS = D_MODEL // HEAD_DIM
D_RWKV = N_HEADS * HEAD_DIM
D_CONV = D_MODEL
CONV_W = 3
LORA_W = 64
LORA_A = 64
RMS_EPS = 1e-6
GN_EPS = 64e-5
CONV_SIZES = [D_CONV, D_CONV, D_CONV, D_CONV]
RWKV_SIZES = [D_RWKV, D_RWKV, D_RWKV, LORA_W, LORA_A, D_RWKV]
N_CONV_COLS = sum(CONV_SIZES)
N_RWKV_COLS = sum(RWKV_SIZES)
N_IN = N_CONV_COLS + N_RWKV_COLS + 2 * D_MODEL

kernel_name = "hybrid_shortconv_rwkv7_gated_merge_step"


def _split(p, sizes):
    idx = np.cumsum(sizes)[:-1].tolist()
    return jnp.split(p, idx, axis=-1)


def _rmsnorm(x, g):
    xf = x.astype(jnp.float32)
    y = xf * lax.rsqrt(jnp.mean(xf * xf, axis=-1, keepdims=True) + RMS_EPS)
    return (y * g.astype(jnp.float32)).astype(x.dtype)


def _rwkv7_scan(S0, r, k, v, decay, kk, a):
    def step(S, inp):
        r_t, k_t, v_t, d_t, kk_t, a_t = inp
        sa = jnp.einsum('bhvk,bhk->bhv', S, -kk_t)
        S = (S * d_t[:, :, None, :] + sa[..., None] * (kk_t * a_t)[:, :, None, :]
             + v_t[..., None] * k_t[:, :, None, :])
        y = jnp.einsum('bhvk,bhk->bhv', S, r_t)
        return S, y
    xs = tuple(jnp.moveaxis(t.astype(jnp.float32), 1, 0) for t in (r, k, v, decay, kk, a))
    S_fin, ys = lax.scan(step, S0.astype(jnp.float32), xs)
    return S_fin, jnp.moveaxis(ys, 0, 1)


def _layer(x, conv_buf, h_last, S0, norm_g, w_in, conv_w, mu_shift, w0, w_up, a0, a_up,
           k_k, k_a, r_k, ln_w, ln_b, w_out_c, w_out_r, w_o):
    b, s, _ = x.shape
    h = _rmsnorm(x, norm_g)
    p = jnp.einsum('bsd,dn->bsn', h, w_in)
    p_conv, p_rwkv, p_gate = _split(p, [N_CONV_COLS, N_RWKV_COLS, 2 * D_MODEL])

    xin, bg, cg, zc = _split(p_conv, CONV_SIZES)
    u = cg * xin
    u_ext = jnp.concatenate([conv_buf.astype(u.dtype), u], axis=1)
    conv = sum(conv_w[j] * u_ext[:, j:j + s] for j in range(CONV_W))
    y_c = bg * conv * jax.nn.silu(zc)
    new_conv = u_ext[:, -(CONV_W - 1):]

    w_r = w_in[:, N_CONV_COLS:N_CONV_COLS + N_RWKV_COLS]
    p_last = jnp.einsum('bd,dn->bn', h_last.astype(h.dtype), w_r)
    prev = jnp.concatenate([p_last[:, None], p_rwkv[:, :-1]], axis=1)
    xm = p_rwkv + (prev - p_rwkv) * mu_shift
    r, k, v, wd, ad, zr = _split(xm, RWKV_SIZES)
    w_logit = w0 + jnp.einsum('bsr,rc->bsc', jnp.tanh(wd), w_up)
    w_log = (-jax.nn.softplus(-w_logit.astype(jnp.float32)) - 0.5)
    decay = jnp.exp(-jnp.exp(w_log))
    a = jax.nn.sigmoid((a0 + jnp.einsum('bsr,rc->bsc', ad, a_up)).astype(jnp.float32))
    hs = (b, s, N_HEADS, HEAD_DIM)
    r_h = r.reshape(hs).astype(jnp.float32)
    v_h = v.reshape(hs).astype(jnp.float32)
    k_f = k.astype(jnp.float32)
    kk = (k_f * k_k).reshape(hs)
    kk = kk / jnp.maximum(jnp.sqrt(jnp.sum(kk * kk, axis=-1, keepdims=True)), 1e-12)
    k_h = (k_f * (1.0 + (a - 1.0) * k_a)).reshape(hs)
    a_h = a.reshape(hs)
    S_fin, ys = _rwkv7_scan(S0, r_h, k_h, v_h, decay.reshape(hs), kk, a_h)
    mu = jnp.mean(ys, axis=-1, keepdims=True)
    var = jnp.mean(jnp.square(ys - mu), axis=-1, keepdims=True)
    yn = ((ys - mu) * lax.rsqrt(var + GN_EPS)).reshape(b, s, D_RWKV) * ln_w + ln_b
    bonus = (jnp.sum(r_h * k_h * r_k, axis=-1, keepdims=True) * v_h).reshape(b, s, D_RWKV)
    y_r = ((yn + bonus) * jax.nn.silu(zr.astype(jnp.float32))).astype(x.dtype)

    gc, gr = _split(p_gate, [D_MODEL, D_MODEL])
    pc = jnp.einsum('bsc,cd->bsd', y_c, w_out_c)
    pr = jnp.einsum('bsc,cd->bsd', y_r, w_out_r)
    m = jax.nn.sigmoid(gc) * pc + jax.nn.sigmoid(gr) * pr
    out = jnp.einsum('bsd,de->bse', m, w_o)
    return x + out, new_conv, h[:, -1], S_fin.astype(S0.dtype)


def setup_inputs(seed: int = 0) -> dict:
    key = jax.random.key(seed)
    ks = jax.random.split(key, 24)
    f = jnp.float32
    n = lambda i, shape, sc: jax.random.normal(ks[i], shape, f) * sc
    L = DEPTH
    return {
        "x_prompt": n(0, (BATCH, SEQ, D_MODEL), 1.0),
        "x_sample": n(1, (DEC_BATCH, DEC_SEQ, D_MODEL), 1.0),
        "state_conv": n(2, (L, DEC_BATCH, CONV_W - 1, D_CONV), 0.5),
        "state_shift": n(3, (L, DEC_BATCH, D_MODEL), 1.0),
        "state_rwkv": n(4, (L, DEC_BATCH, N_HEADS, HEAD_DIM, HEAD_DIM), 0.3),
        "norm_g": 1.0 + n(5, (L, D_MODEL), 0.05),
        "w_in": n(6, (L, D_MODEL, N_IN), D_MODEL ** -0.5),
        "conv_w": n(7, (L, CONV_W, D_CONV), CONV_W ** -0.5),
        "mu_shift": jax.random.uniform(ks[8], (L, N_RWKV_COLS), f),
        "w0": jax.random.uniform(ks[9], (L, D_RWKV), f, -4.0, 1.0),
        "w_up": n(10, (L, LORA_W, D_RWKV), 0.5 * LORA_W ** -0.5),
        "a0": n(11, (L, D_RWKV), 0.5),
        "a_up": n(12, (L, LORA_A, D_RWKV), 0.5 * LORA_A ** -0.5),
        "k_k": 0.85 + n(13, (L, D_RWKV), 0.05),
        "k_a": 1.0 + n(14, (L, D_RWKV), 0.05),
        "r_k": n(15, (L, N_HEADS, HEAD_DIM), 0.1),
        "ln_w": 1.0 + n(16, (L, D_RWKV), 0.05),
        "ln_b": n(17, (L, D_RWKV), 0.02),
        "w_out_c": n(18, (L, D_CONV, D_MODEL), D_CONV ** -0.5),
        "w_out_r": n(19, (L, D_RWKV, D_MODEL), D_RWKV ** -0.5),
        "w_o": n(20, (L, D_MODEL, D_MODEL), D_MODEL ** -0.5),
        "final_g": 1.0 + n(21, (D_MODEL,), 0.05),
    }


def reference(x_prompt, x_sample, state_conv, state_shift, state_rwkv, norm_g, w_in, conv_w,
              mu_shift, w0, w_up, a0, a_up, k_k, k_a, r_k, ln_w, ln_b, w_out_c, w_out_r, w_o,
              final_g):
    bp = x_prompt.shape[0]
    xp, xs = x_prompt, x_sample
    cp, sp, rp, cs, ss, rs = [], [], [], [], [], []
    for l in range(DEPTH):
        wl = (norm_g[l], w_in[l], conv_w[l], mu_shift[l], w0[l], w_up[l], a0[l], a_up[l],
              k_k[l], k_a[l], r_k[l], ln_w[l], ln_b[l], w_out_c[l], w_out_r[l], w_o[l])
        conv0 = jnp.zeros((bp, CONV_W - 1, D_CONV), x_prompt.dtype)
        shift0 = jnp.zeros((bp, D_MODEL), x_prompt.dtype)
        S00 = jnp.zeros((bp, N_HEADS, HEAD_DIM, HEAD_DIM), state_rwkv.dtype)
        xp, c1, s1, r1 = _layer(xp, conv0, shift0, S00, *wl)
        xs, c2, s2, r2 = _layer(xs, state_conv[l], state_shift[l], state_rwkv[l], *wl)
        cp.append(c1); sp.append(s1); rp.append(r1)
        cs.append(c2); ss.append(s2); rs.append(r2)
    y_prompt = _rmsnorm(xp, final_g)
    y_sample = _rmsnorm(xs, final_g)
    return (y_prompt, y_sample, jnp.stack(cp), jnp.stack(sp), jnp.stack(rp),
            jnp.stack(cs), jnp.stack(ss), jnp.stack(rs))
```

```cpp
#include <hip/hip_runtime.h>
#include <cstdio>
#include <cstdint>
namespace pg8 {
#define PG8_LAS __attribute__((address_space(3)))
typedef unsigned short bf16_t;
typedef short bf16x8 __attribute__((ext_vector_type(8)));
typedef float f32x4 __attribute__((ext_vector_type(4)));
typedef unsigned u32x4 __attribute__((ext_vector_type(4)));
constexpr int BM = 256, BK = 64, HALF = 128, HTB = HALF * BK * 2  , STAGE_BYTES = 8 * HTB, NXCD = 8, WGM = 8;

__host__ __device__ __forceinline__ int lds_byte(int r, int c) { const int st = (r >> 4) * 2 + (c >> 5), rr = r & 15, cc = c & 31, ob = rr * 64 + cc * 2; return st * 1024 + (ob ^ (((ob >> 9) & 1) << 5)); }
__host__ __device__ __forceinline__ void stage_rc(int b, int& R, int& C) { const int st = b / 1024, sb = b % 1024, swz = sb ^ (((sb >> 9) & 1) << 5); R = (st >> 1) * 16 + swz / 64; C = (st & 1) * 32 + (swz % 64) / 2; }
__host__ __device__ __forceinline__ int perm32(int rho) { const int n = rho >> 4, i = rho & 15; return 8 * (i >> 2) + 4 * n + (i & 3); }

struct Unit { int pm, pn; };
struct Gemm { const bf16_t* A; const bf16_t* Bt; int M, N, K; };

struct StaticOrder {
    int nM, nN, nwg, G, c;
    __host__ __device__ void init(int M, int N, int G_, int c_) { nM = M / BM; nN = N / BM; nwg = nM * nN; G = G_; c = c_; }
    __host__ __device__ bool next(int i, Unit& u) const {
        const long L = (long)i * G + c; if (L >= nwg) return false;
        int wgid = (int)L; { const int q = nwg / NXCD, r = nwg % NXCD, xcd = wgid % NXCD, off = wgid / NXCD; wgid = (xcd < r ? xcd * (q + 1) : r * (q + 1) + (xcd - r) * q) + off; }
        const int nig = WGM * nN, gid = wgid / nig, fm = gid * WGM, gsz = (nM - fm) < WGM ? (nM - fm) : WGM;
        u.pm = fm + ((wgid % nig) % gsz); u.pn = (wgid % nig) / gsz; return true;
    }
    __device__ __forceinline__ void a_ready(const Unit&) const {}
    __device__ __forceinline__ void done(const Unit&) const {}
};

template <class Epi, class Sched, bool ALIGN_EPI = false, bool SP2 = false>
__device__ __forceinline__ void gemm_phase(PG8_LAS unsigned char* lds, const Gemm g, const Sched& S, const Epi& E) {
    const int tid = threadIdx.x, wid = __builtin_amdgcn_readfirstlane(tid >> 6), lane = tid & 63, wr = wid >> 2, wc = wid & 3, fr = lane & 15, fq = lane >> 4;
    const int K = g.K, nt = K / BK;
    unsigned voffA[2], voffB[2];
#pragma unroll
    for (int i = 0; i < 2; ++i) { int R, C; stage_rc(tid * 16 + i * 8192, R, C); const int Rb = Epi::PERM ? ((R & ~31) + perm32(R & 31)) : R;
        voffA[i] = (unsigned)(R * K + C) * 2u; voffB[i] = (unsigned)(Rb * K + C) * 2u; }
    const size_t kstep = (size_t)(BK * 2);
    const size_t hstep = (size_t)HALF * K * 2;
    const size_t tstep = 2 * hstep;
    const unsigned ldsw = (unsigned)wid * 1024u;
    const int aoff = lds_byte(wr * 64 + fr, fq * 8), boff = lds_byte(wc * 32 + fr, fq * 8);
#define PG8_SA(b, h) (((b) * 2 + (h)) * HTB)
#define PG8_SB(b, h) ((4 + (b) * 2 + (h)) * HTB)
#define PG8_STAGE(bufoff, gbase, voff) do { _Pragma("unroll") for (int _i = 0; _i < 2; ++_i) \
        __builtin_amdgcn_global_load_lds((const unsigned*)((const char*)(gbase) + (voff)[_i]), (PG8_LAS unsigned*)(lds + (bufoff) + ldsw + _i * 8192), 16, 0, 0); } while (0)
#define PG8_LDA(dst, b, h) do { _Pragma("unroll") for (int m = 0; m < 4; ++m) _Pragma("unroll") for (int k = 0; k < 2; ++k) dst[m][k] = *(const PG8_LAS bf16x8*)(lds + PG8_SA(b, h) + aoff + m * 2048 + k * 1024); } while (0)
#define PG8_LDB(dst, b, h) do { _Pragma("unroll") for (int n = 0; n < 2; ++n) _Pragma("unroll") for (int k = 0; k < 2; ++k) dst[n][k] = *(const PG8_LAS bf16x8*)(lds + PG8_SB(b, h) + boff + n * 2048 + k * 1024); } while (0)
#define PG8_MMA(ai, bj, At, Bt) do { __builtin_amdgcn_s_setprio(1); _Pragma("unroll") for (int m = 0; m < 4; ++m) _Pragma("unroll") for (int n = 0; n < 2; ++n) _Pragma("unroll") for (int k = 0; k < 2; ++k) \
        acc[ai][bj][m][n] = __builtin_amdgcn_mfma_f32_16x16x32_bf16(Bt[n][k], At[m][k], acc[ai][bj][m][n], 0, 0, 0); __builtin_amdgcn_s_setprio(0); } while (0)
#define PG8_WAIT_V(n) asm volatile("s_waitcnt vmcnt(" #n ")" ::: "memory")
#define PG8_WAIT_L(n) asm volatile("s_waitcnt lgkmcnt(" #n ")" ::: "memory")
#define PG8_BAR __builtin_amdgcn_s_barrier()
#define PG8_SCHED __builtin_amdgcn_sched_barrier(0)
    Unit cur, nxt; int ui = 0;
    if (!S.next(0, cur)) return;
    f32x4 acc[2][2][4][2];
#pragma unroll
    for (int a = 0; a < 2; ++a)
#pragma unroll
        for (int b = 0; b < 2; ++b)
#pragma unroll
            for (int m = 0; m < 4; ++m)
#pragma unroll
                for (int n = 0; n < 2; ++n) acc[a][b][m][n] = (f32x4){0.f, 0.f, 0.f, 0.f};
    bf16x8 At[4][2], B0[2][2], B1[2][2];
    const char* cA = (const char*)g.A + (size_t)cur.pm * tstep; const char* cB = (const char*)g.Bt + (size_t)cur.pn * tstep;
    S.a_ready(cur);
    if constexpr (SP2) {
        PG8_STAGE(PG8_SB(0, 0), cB, voffB); PG8_STAGE(PG8_SB(0, 1), cB + hstep, voffB); PG8_STAGE(PG8_SA(0, 0), cA, voffA); PG8_STAGE(PG8_SA(0, 1), cA + hstep, voffA);
        if (wr == 1) PG8_BAR;
        PG8_WAIT_V(2); PG8_BAR;
        PG8_STAGE(PG8_SB(1, 0), cB + kstep, voffB); PG8_STAGE(PG8_SA(1, 0), cA + kstep, voffA); PG8_STAGE(PG8_SB(1, 1), cB + hstep + kstep, voffB);
        PG8_WAIT_V(6); PG8_BAR;
    } else {
        PG8_STAGE(PG8_SB(0, 0), cB, voffB); PG8_STAGE(PG8_SA(0, 0), cA, voffA); PG8_STAGE(PG8_SB(0, 1), cB + hstep, voffB); PG8_STAGE(PG8_SA(0, 1), cA + hstep, voffA);
        if (wr == 1) PG8_BAR;
        PG8_WAIT_V(4); PG8_BAR;
        PG8_STAGE(PG8_SB(1, 0), cB + kstep, voffB); PG8_STAGE(PG8_SA(1, 0), cA + kstep, voffA); PG8_STAGE(PG8_SB(1, 1), cB + hstep + kstep, voffB);
        PG8_WAIT_V(6); PG8_BAR;
    }
    for (;;) {
        const bool has_next = S.next(ui + 1, nxt);
        const char* nA = has_next ? (const char*)g.A + (size_t)nxt.pm * tstep : cA; const char* nB = has_next ? (const char*)g.Bt + (size_t)nxt.pn * tstep : cB;
        for (int t = 0; t < nt; t += 2) {
            const bool last = (t == nt - 2);
            const char* a1 = cA + (size_t)(t + 1) * kstep;
            const char* a2 = last ? nA : cA + (size_t)(t + 2) * kstep; const char* b2 = last ? nB : cB + (size_t)(t + 2) * kstep;
            const char* a3 = a2 + kstep; const char* b3 = b2 + kstep;
            if (last && has_next) S.a_ready(nxt);
            if constexpr (SP2) {
            PG8_LDB(B0, 0, 0); PG8_LDB(B1, 0, 1); PG8_SCHED; PG8_LDA(At, 0, 0); PG8_STAGE(PG8_SA(1, 1), a1 + hstep, voffA);
            PG8_WAIT_V(8); PG8_WAIT_L(0); PG8_BAR; PG8_MMA(0, 0, At, B0); PG8_MMA(0, 1, At, B1); PG8_BAR; PG8_SCHED;
            PG8_LDA(At, 0, 1); PG8_STAGE(PG8_SB(0, 0), b2, voffB); PG8_STAGE(PG8_SB(0, 1), b2 + hstep, voffB); PG8_STAGE(PG8_SA(0, 0), a2, voffA);
            PG8_WAIT_V(8); PG8_WAIT_L(0); PG8_BAR; PG8_MMA(1, 0, At, B0); PG8_MMA(1, 1, At, B1); PG8_BAR; PG8_SCHED;
            PG8_LDB(B0, 1, 0); PG8_LDB(B1, 1, 1); PG8_SCHED; PG8_LDA(At, 1, 0); PG8_STAGE(PG8_SA(0, 1), a2 + hstep, voffA);
            PG8_WAIT_V(8); PG8_WAIT_L(0); PG8_BAR; PG8_MMA(0, 0, At, B0); PG8_MMA(0, 1, At, B1); PG8_BAR; PG8_SCHED;
            PG8_LDA(At, 1, 1); PG8_STAGE(PG8_SB(1, 0), b3, voffB); PG8_STAGE(PG8_SB(1, 1), b3 + hstep, voffB); PG8_STAGE(PG8_SA(1, 0), a3, voffA);
            PG8_WAIT_V(8); PG8_WAIT_L(0); PG8_BAR; PG8_MMA(1, 0, At, B0); PG8_MMA(1, 1, At, B1); PG8_BAR; PG8_SCHED;
            } else {
            PG8_LDB(B0, 0, 0); PG8_SCHED; PG8_LDA(At, 0, 0); PG8_STAGE(PG8_SA(1, 1), a1 + hstep, voffA);
            PG8_WAIT_L(8); PG8_BAR; PG8_WAIT_L(0); PG8_MMA(0, 0, At, B0); PG8_BAR; PG8_SCHED;
            PG8_LDB(B1, 0, 1); PG8_STAGE(PG8_SB(0, 0), b2, voffB);
            PG8_BAR; PG8_WAIT_L(0); PG8_MMA(0, 1, At, B1); PG8_BAR;
            PG8_LDA(At, 0, 1); PG8_STAGE(PG8_SA(0, 0), a2, voffA);
            PG8_BAR; PG8_WAIT_L(0); PG8_MMA(1, 0, At, B0); PG8_BAR; PG8_SCHED;
            PG8_STAGE(PG8_SB(0, 1), b2 + hstep, voffB);
            PG8_WAIT_V(6); PG8_BAR; PG8_MMA(1, 1, At, B1); PG8_BAR;
            PG8_LDB(B0, 1, 0); PG8_SCHED; PG8_LDA(At, 1, 0); PG8_STAGE(PG8_SA(0, 1), a2 + hstep, voffA);
            PG8_WAIT_L(8); PG8_BAR; PG8_WAIT_L(0); PG8_MMA(0, 0, At, B0); PG8_BAR; PG8_SCHED;
            PG8_LDB(B1, 1, 1); PG8_STAGE(PG8_SB(1, 0), b3, voffB);
            PG8_BAR; PG8_WAIT_L(0); PG8_MMA(0, 1, At, B1); PG8_BAR;
            PG8_LDA(At, 1, 1); PG8_STAGE(PG8_SA(1, 0), a3, voffA);
            PG8_BAR; PG8_WAIT_L(0); PG8_MMA(1, 0, At, B0); PG8_BAR; PG8_SCHED;
            PG8_STAGE(PG8_SB(1, 1), b3 + hstep, voffB);
            PG8_WAIT_V(6); PG8_BAR; PG8_MMA(1, 1, At, B1); PG8_BAR;
            }
        }
        if constexpr (ALIGN_EPI) { if (wr == 0) PG8_BAR; }
        if constexpr (!Epi::AFTER_DRAIN) { E(acc, cur, wr, wc, fr, fq); S.done(cur); }
        if (!has_next) break;
#pragma unroll
        for (int a = 0; a < 2; ++a)
#pragma unroll
            for (int b = 0; b < 2; ++b)
#pragma unroll
                for (int m = 0; m < 4; ++m)
#pragma unroll
                    for (int n = 0; n < 2; ++n) acc[a][b][m][n] = (f32x4){0.f, 0.f, 0.f, 0.f};
        cur = nxt; cA = nA; cB = nB; ++ui;
        if constexpr (ALIGN_EPI) { if (wr == 1) PG8_BAR; }
    }
    PG8_WAIT_V(0);
    if constexpr (!ALIGN_EPI) { if (wr == 0) PG8_BAR; }
    PG8_BAR;
    if constexpr (Epi::AFTER_DRAIN) { E.fused(acc, cur, wr, wc, fr, fq, lds, wid, lane); S.done(cur); }
#undef PG8_SA
#undef PG8_SB
#undef PG8_STAGE
#undef PG8_LDA
#undef PG8_LDB
#undef PG8_MMA
#undef PG8_WAIT_V
#undef PG8_WAIT_L
#undef PG8_BAR
#undef PG8_SCHED
}
}
#define GAS __attribute__((address_space(1)))
#define LAS __attribute__((address_space(3)))
typedef unsigned short bf16;
typedef unsigned v4u __attribute__((ext_vector_type(4)));
typedef float f32x4 __attribute__((ext_vector_type(4)));
typedef short bf16x8 __attribute__((ext_vector_type(8)));
typedef GAS unsigned gu32;
typedef GAS unsigned long long gu64;
#define RLX_AGENT __ATOMIC_RELAXED, __HIP_MEMORY_SCOPE_AGENT
#define LDS_WAIT() asm volatile("s_waitcnt lgkmcnt(0)" ::: "memory")
#define VM_WAIT() asm volatile("s_waitcnt vmcnt(0)" ::: "memory")
__device__ __forceinline__ unsigned long long rt() { return __builtin_amdgcn_s_memrealtime(); }
__device__ __forceinline__ unsigned f2bf(float f) { unsigned u = __builtin_bit_cast(unsigned, f); return (u + 0x7fffu + ((u >> 16) & 1u)) >> 16; }
__device__ __forceinline__ unsigned pk2(float lo, float hi) { return f2bf(lo) | (f2bf(hi) << 16); }

#define XB_TMO      128
#define XB_XCNT(j)  (256  + 64 * (j))
#define XB_XSUB(j)  (1280 + 64 * (j))
#define XB_XGEN(j)  (2304 + 64 * (j))
#define XB_TOP      3328
#define XB_TOPGEN   3392
#define XCD_BAR_WORDS 3456
#define XB_SPIN_CAP (1u << 18)

__device__ __forceinline__ unsigned xb_ld(unsigned* p)              { return __hip_atomic_load(p, __ATOMIC_RELAXED, __HIP_MEMORY_SCOPE_AGENT); }
__device__ __forceinline__ unsigned xb_add(unsigned* p, unsigned v) { return __hip_atomic_fetch_add(p, v, __ATOMIC_RELAXED, __HIP_MEMORY_SCOPE_AGENT); }
__device__ __forceinline__ unsigned xb_xcc_id() { return (unsigned)__builtin_amdgcn_s_getreg((3 << 11) | 20) & 0xFu; }
#define XB_SPIN(cond, bar) do { unsigned _sp = 0; while (cond) { __builtin_amdgcn_s_sleep(1); \
    if ((++_sp & 255u) == 0u) { if (xb_ld(&(bar)[XB_TMO])) break; if (_sp > XB_SPIN_CAP) { atomicAdd(&(bar)[XB_TMO], 1u); break; } } } } while (0)

struct XcdBarrier {
    unsigned* bar; unsigned x;
    volatile LAS unsigned* st;
};

__device__ __forceinline__ XcdBarrier xcd_barrier_post(unsigned* bar, volatile LAS unsigned* st) {
    XcdBarrier b; b.bar = bar; b.x = xb_xcc_id(); b.st = st;
    if (threadIdx.x == 0) (void)xb_add(&bar[XB_XCNT(b.x)], 1u);
    return b;
}
__device__ __forceinline__ void xcd_barrier_complete(unsigned* bar, unsigned x, unsigned& nloc, unsigned& nx) {
    const unsigned G = gridDim.x * gridDim.y * gridDim.z;
    unsigned sum, cnt, mine, sp = 0u;
    for (;;) {
        sum = 0u; cnt = 0u; mine = 0u;
#pragma unroll
        for (unsigned j = 0; j < 16; ++j) { const unsigned c = xb_ld(&bar[XB_XCNT(j)]); sum += c; cnt += (c > 0u) ? 1u : 0u; mine = (j == x) ? c : mine; }
        if (sum == G) break;
        __builtin_amdgcn_s_sleep(1);
        if ((++sp & 255u) == 0u) { if (xb_ld(&bar[XB_TMO])) break; if (sp > XB_SPIN_CAP) { atomicAdd(&bar[XB_TMO], 1u); break; } }
    }
    nloc = mine > 0u ? mine : 1u; nx = cnt > 0u ? cnt : 1u;
}

__device__ __forceinline__ void xcd_barrier(const XcdBarrier& b) {
    asm volatile("s_waitcnt vmcnt(0)" ::: "memory");
    __syncthreads();
    if (threadIdx.x == 0) {
        unsigned* bar = b.bar;
        __builtin_amdgcn_s_waitcnt(0);
        unsigned nloc = b.st[0], nx = b.st[1];
        if (nloc == 0u) { xcd_barrier_complete(bar, b.x, nloc, nx); b.st[0] = nloc; b.st[1] = nx; }
        const unsigned old = xb_add(&bar[XB_XSUB(b.x)], 1u);
        const unsigned gen = old / nloc;
        if (old + 1u == (gen + 1u) * nloc) {
            __builtin_amdgcn_fence(__ATOMIC_RELEASE, "agent");
            asm volatile("s_waitcnt vmcnt(0)" ::: "memory");
            const unsigned og = xb_add(&bar[XB_TOP], 1u);
            const unsigned tg = og / nx;
            if (og + 1u == (tg + 1u) * nx) xb_add(&bar[XB_TOPGEN], 1u);
            else XB_SPIN(xb_ld(&bar[XB_TOPGEN]) == tg, bar);
            __builtin_amdgcn_fence(__ATOMIC_ACQUIRE, "agent");
            xb_add(&bar[XB_XGEN(b.x)], 1u);
            asm volatile("s_waitcnt vmcnt(0)" ::: "memory");
        } else {
            XB_SPIN(xb_ld(&bar[XB_XGEN(b.x)]) == gen, bar);
            __builtin_amdgcn_fence(__ATOMIC_ACQUIRE, "agent");
            asm volatile("s_waitcnt vmcnt(0)" ::: "memory");
        }
    }
    __syncthreads();
}

constexpr int NWAVES = 8;
constexpr int D = 1024, NPR = 16384, NSR = 512, NROW = NPR + NSR, NROWP = 17152;
constexpr int SEQ = 2048, DBATCH = 128, NH = 16;
constexpr int N_IN = 10368, NT_IN = 41;
constexpr float RMS_EPS = 1e-6f, GN_EPS = 64e-5f;
#ifndef MK_N_LAUNCHES
#define MK_N_LAUNCHES 1
#endif
constexpr int N_PHASES = 7;
constexpr int N_LAUNCHES = MK_N_LAUNCHES;

constexpr size_t MiB = 1u << 20;
constexpr size_t WS_CTL = 0, CTL_ZERO_BYTES = 64 * 1024;
constexpr size_t WS_WOC = 1 * MiB, WS_WOR = 3 * MiB, WS_WO = 5 * MiB;
constexpr size_t WS_STATS = 7 * MiB;
constexpr size_t WS_SGS = 9 * MiB;
constexpr size_t WS_H = 11 * MiB;
constexpr size_t WS_U = 45 * MiB, WS_GC = 78 * MiB;
constexpr size_t WS_R = 111 * MiB, WS_K = 145 * MiB, WS_V = 179 * MiB, WS_ZR = 213 * MiB;
constexpr size_t WS_WA = 247 * MiB;
constexpr size_t WS_END = 256 * MiB;
constexpr size_t RKVZ_STRIDE = (WS_K - WS_R) / 2;
static_assert(WS_V - WS_K == WS_K - WS_R && WS_ZR - WS_V == WS_K - WS_R, "R|K|V|ZR equally spaced");
static_assert(WS_H + (size_t)NROWP * D * 2 <= WS_U && WS_U + (size_t)NROW * D * 2 <= WS_GC && WS_GC + (size_t)NROW * D * 2 <= WS_R && WS_U + (size_t)NROW * D * 4 <= WS_R, "ws map 1");
static_assert(WS_R + (size_t)NROWP * D * 2 <= WS_K && WS_ZR + (size_t)NROWP * D * 2 <= WS_WA && WS_WA + (size_t)NROWP * 256 * 2 <= WS_END, "ws map 2");
constexpr size_t O_Y = 0, O_NCP = 17301504, O_NSP = 17317888, O_NRP = 17326080, O_NCS = 17850368, O_NSS = 18112512, O_NRS = 18243584, O_END = 26632192;
static_assert((size_t)NT_IN * 256 * D * 2 <= (O_END - O_NRS) * 4, "Wt_in fits in the new_rwkv_sample region");
constexpr int CW_BAR = 4096;

constexpr int RING_OFF = 0, RING_BYTES = 131072;
constexpr int LDSCTL_OFF = RING_BYTES, MISC_OFF = LDSCTL_OFF + 320;
constexpr int LDS_BYTES = 147456;

typedef unsigned u32x2 __attribute__((ext_vector_type(2)));
__device__ __forceinline__ float bf2f(unsigned short h) { return __uint_as_float((unsigned)h << 16); }
__device__ __forceinline__ float bflo(unsigned w) { return __uint_as_float(w << 16); }
__device__ __forceinline__ float bfhi(unsigned w) { return __uint_as_float(w & 0xffff0000u); }
__device__ __forceinline__ float sigmoidf_(float x) { return __builtin_amdgcn_rcpf(1.0f + __expf(-x)); }
__device__ __forceinline__ float wave_sum(float v) {
#pragma unroll
    for (int o = 1; o < 64; o <<= 1) v += __shfl_xor(v, o);
    return v;
}
__host__ __device__ __forceinline__ int col2slot(int c) { return (c & ~31) | (((c >> 2) & 1) << 4) | (((c >> 3) & 3) << 2) | (c & 3); }
__device__ __forceinline__ int win_dst_row(int n) {
    if (n < 4096) { const int g = n >> 10, ch = n & 1023, pn = ch >> 6, cl = ch & 63;
        return pn * 256 + ((g >> 1) << 7) + ((cl >> 4) << 5) + ((g & 1) << 4) + (cl & 15); }
    if (n < 7168) { const int cc = n - 4096; return (16 + (cc >> 8)) * 256 + col2slot(cc & 255); }
    if (n < 7296) return 32 * 256 + col2slot(n - 7168);
    if (n < 8320) { const int cc = n - 7296; return (28 + (cc >> 8)) * 256 + col2slot(cc & 255); }
    { const int cc = n - 8320; return (33 + (cc >> 8)) * 256 + col2slot(cc & 255); }
}

struct P1Order {
    int G, c;
    __device__ __forceinline__ bool next(int i, pg8::Unit& u) const {
        constexpr int nM = 66, nN = NT_IN, nwg = nM * nN;
        const int L = i * G + c; if (L >= nwg + 17) return false;
        if (L >= nwg) { u.pm = 66; u.pn = 16 + (L - nwg); return true; }
        int wgid = L; { const int q = nwg / 8, r = nwg % 8, xcd = wgid % 8, off = wgid / 8; wgid = (xcd < r ? xcd * (q + 1) : r * (q + 1) + (xcd - r) * q) + off; }
        const int nig = 8 * nN, gid = wgid / nig, fm = gid * 8, gsz = (nM - fm) < 8 ? (nM - fm) : 8;
        u.pm = fm + ((wgid % nig) % gsz); u.pn = (wgid % nig) / gsz; return true;
    }
    __device__ __forceinline__ void a_ready(const pg8::Unit&) const {}
    __device__ __forceinline__ void done(const pg8::Unit&) const {}
};

typedef v4u u32x4; typedef bf16 bf16_t;
__device__ __forceinline__ unsigned cvt_pk_bf16(float lo, float hi) { unsigned r; asm volatile("v_cvt_pk_bf16_f32 %0, %1, %2" : "=v"(r) : "v"(lo), "v"(hi)); return r; }
__device__ __forceinline__ u32x4 pack8(const f32x4 v0, const f32x4 v1) { u32x4 w; w.x = cvt_pk_bf16(v0[0], v0[1]); w.y = cvt_pk_bf16(v0[2], v0[3]); w.z = cvt_pk_bf16(v1[0], v1[1]); w.w = cvt_pk_bf16(v1[2], v1[3]); return w; }

struct EpiP1 {
    static constexpr bool PERM = false, AFTER_DRAIN = false;
    bf16_t *U, *GC, *R, *WA, *SGCp, *SGCs; float *ncp, *ncs;
    __device__ __forceinline__ void operator()(const f32x4 (&acc)[2][2][4][2], const pg8::Unit& u, int wr, int wc, int fr, int fq) const {
        const int row0 = u.pm * 256 + wr * 64 + fr;
        if (u.pn < 16) {
            const int ch = u.pn * 64 + wc * 16 + fq * 4;
#pragma unroll
            for (int ai = 0; ai < 2; ++ai)
#pragma unroll
                for (int m = 0; m < 4; ++m) {
                    const int row = row0 + ai * 128 + m * 16;
                    const f32x4 xin = acc[ai][0][m][0], bg = acc[ai][0][m][1], cg = acc[ai][1][m][0], zc = acc[ai][1][m][1];
                    f32x4 uu, gg;
#pragma unroll
                    for (int j = 0; j < 4; ++j) { uu[j] = cg[j] * xin[j]; gg[j] = bg[j] * zc[j] * sigmoidf_(zc[j]); }
                    u32x2 wu, wg; wu.x = cvt_pk_bf16(uu[0], uu[1]); wu.y = cvt_pk_bf16(uu[2], uu[3]); wg.x = cvt_pk_bf16(gg[0], gg[1]); wg.y = cvt_pk_bf16(gg[2], gg[3]);
                    *(u32x2*)(U + (size_t)row * D + ch) = wu; *(u32x2*)(GC + (size_t)row * D + ch) = wg;
                    if (row < NPR) { const int t = row & (SEQ - 1); if (t >= SEQ - 2) *(f32x4*)(ncp + ((size_t)(row >> 11) * 2 + (t - (SEQ - 2))) * D + ch) = uu; }
                    else { const int rs = row - NPR, t = rs & 3; if (t >= 2) *(f32x4*)(ncs + ((size_t)(rs >> 2) * 2 + (t - 2)) * D + ch) = uu; }
                }
            return;
        }
        bf16_t* base; int ldc = D, colt; bool sig = false;
        if (u.pn < 32) { const int g = (u.pn - 16) >> 2; base = R + (size_t)g * RKVZ_STRIDE; colt = ((u.pn - 16) & 3) * 256; }
        else if (u.pn == 32) { base = WA; ldc = 256; colt = 0; }
        else { sig = true; const int g = (u.pn - 33) >> 2; colt = ((u.pn - 33) & 3) * 256;
               if (u.pm < 64) base = SGCp + (size_t)g * NPR * D; else base = SGCs + (size_t)g * NSR * D - (size_t)NPR * D; }
        const int col0 = colt + wc * 32 + 8 * fq;
#pragma unroll
        for (int ai = 0; ai < 2; ++ai)
#pragma unroll
            for (int m = 0; m < 4; ++m) { bf16_t* rowp = base + (size_t)(row0 + ai * 128 + m * 16) * ldc + col0;
#pragma unroll
                for (int bj = 0; bj < 2; ++bj) { f32x4 v0 = acc[ai][bj][m][0], v1 = acc[ai][bj][m][1];
                    if (sig) {
#pragma unroll
                        for (int j = 0; j < 4; ++j) { v0[j] = sigmoidf_(v0[j]); v1[j] = sigmoidf_(v1[j]); } }
                    *(u32x4*)(rowp + bj * 128) = pack8(v0, v1); } }
    }
};
__device__ __forceinline__ void unpack8(const u32x4 w, f32x4& a, f32x4& b) { a[0] = bflo(w.x); a[1] = bfhi(w.x); a[2] = bflo(w.y); a[3] = bfhi(w.y); b[0] = bflo(w.z); b[1] = bfhi(w.z); b[2] = bflo(w.w); b[3] = bfhi(w.w); }
struct EpiT1 {
    static constexpr bool PERM = false, AFTER_DRAIN = false;
    float* T1; const bf16_t *SGp, *SGs;
    __device__ __forceinline__ void operator()(const f32x4 (&acc)[2][2][4][2], const pg8::Unit& u, int wr, int wc, int fr, int fq) const {
        const int row0 = u.pm * 256 + wr * 64 + fr, col0 = u.pn * 256 + wc * 32 + 8 * fq;
        const bf16_t* sg = u.pm < 64 ? SGp : SGs - (size_t)NPR * D;
#pragma unroll
        for (int ai = 0; ai < 2; ++ai)
#pragma unroll
            for (int m = 0; m < 4; ++m) { const size_t off = (size_t)(row0 + ai * 128 + m * 16) * D + col0;
#pragma unroll
                for (int bj = 0; bj < 2; ++bj) { f32x4 g0, g1; unpack8(*(const u32x4*)(sg + off + bj * 128), g0, g1);
                    *(f32x4*)(T1 + off + bj * 128) = acc[ai][bj][m][0] * g0; *(f32x4*)(T1 + off + bj * 128 + 4) = acc[ai][bj][m][1] * g1; } }
    }
};
struct EpiM {
    static constexpr bool PERM = false, AFTER_DRAIN = false;
    const float* T1; bf16_t* M; const bf16_t *SGp, *SGs;
    __device__ __forceinline__ void operator()(const f32x4 (&acc)[2][2][4][2], const pg8::Unit& u, int wr, int wc, int fr, int fq) const {
        const int row0 = u.pm * 256 + wr * 64 + fr, col0 = u.pn * 256 + wc * 32 + 8 * fq;
        const bf16_t* sg = u.pm < 64 ? SGp : SGs - (size_t)NPR * D;
#pragma unroll
        for (int ai = 0; ai < 2; ++ai)
#pragma unroll
            for (int m = 0; m < 4; ++m) { const size_t off = (size_t)(row0 + ai * 128 + m * 16) * D + col0;
#pragma unroll
                for (int bj = 0; bj < 2; ++bj) { f32x4 g0, g1; unpack8(*(const u32x4*)(sg + off + bj * 128), g0, g1);
                    const f32x4 t0 = *(const f32x4*)(T1 + off + bj * 128), t1 = *(const f32x4*)(T1 + off + bj * 128 + 4);
                    *(u32x4*)(M + off + bj * 128) = pack8(t0 + acc[ai][bj][m][0] * g0, t1 + acc[ai][bj][m][1] * g1); } }
    }
};
struct EpiXo {
    static constexpr bool PERM = false, AFTER_DRAIN = false;
    const float *xp, *xs; float* out; float* stats;
    __device__ __forceinline__ void operator()(const f32x4 (&acc)[2][2][4][2], const pg8::Unit& u, int wr, int wc, int fr, int fq) const {
        const int row0 = u.pm * 256 + wr * 64 + fr, col0 = u.pn * 256 + wc * 32 + 8 * fq;
        const float* x = u.pm < 64 ? xp : xs - (size_t)NPR * D;
#pragma unroll
        for (int ai = 0; ai < 2; ++ai)
#pragma unroll
            for (int m = 0; m < 4; ++m) { const int row = row0 + ai * 128 + m * 16; const size_t off = (size_t)row * D + col0; float ss = 0.f;
#pragma unroll
                for (int bj = 0; bj < 2; ++bj) {
                    const f32x4 o0 = *(const f32x4*)(x + off + bj * 128) + acc[ai][bj][m][0], o1 = *(const f32x4*)(x + off + bj * 128 + 4) + acc[ai][bj][m][1];
                    *(f32x4*)(out + off + bj * 128) = o0; *(f32x4*)(out + off + bj * 128 + 4) = o1;
                    ss += (o0[0] * o0[0] + o0[1] * o0[1]) + (o0[2] * o0[2] + o0[3] * o0[3]) + (o1[0] * o1[0] + o1[1] * o1[1]) + (o1[2] * o1[2] + o1[3] * o1[3]); }
                ss += __shfl_xor(ss, 16); ss += __shfl_xor(ss, 32);
                if (fq == 0) stats[(size_t)row * 16 + u.pn * 4 + wc] = ss; }
    }
};

struct Frame {
    LAS unsigned char* lds;
    volatile LAS unsigned* MISC;
    gu32* ctl;
    int tid, lane, wave, G;
    const float *x_prompt, *x_sample, *state_conv, *state_shift, *state_rwkv, *norm_g, *w_in, *conv_w, *mu, *w0, *w_up, *a0, *a_up, *k_k, *k_a, *r_k, *ln_w, *ln_b, *w_out_c, *w_out_r, *w_o, *final_g;
    float* out;
    bf16 *Wt_in, *Wt_oc, *Wt_or, *Wt_o, *H, *U, *GC, *R, *K, *V, *ZR, *WA, *SGCp, *SGRp, *SGCs, *SGRs;
    float *T1, *STATS;
};

template <class DST>
__device__ __forceinline__ void p0_transpose_item(const float* W, int K, int N, bf16* WT, LAS float* scr, int item, int lane, DST dst) {
    const int nblk = N / 32, kb = item / nblk, nb = item % nblk, k0 = 64 * kb, n0 = 32 * nb;
#pragma unroll 8
    for (int i = 0; i < 32; ++i) { const int kk = 2 * i + (lane >> 5); scr[kk * 33 + (lane & 31)] = W[(size_t)(k0 + kk) * N + n0 + (lane & 31)]; }
    LDS_WAIT(); asm volatile("" ::: "memory");
    const int c = lane & 7;
#pragma unroll
    for (int j = 0; j < 4; ++j) { const int n = (lane >> 3) + 8 * j; const LAS float* s = scr + (8 * c) * 33 + n;
        v4u o; o.x = pk2(s[0 * 33], s[1 * 33]); o.y = pk2(s[2 * 33], s[3 * 33]); o.z = pk2(s[4 * 33], s[5 * 33]); o.w = pk2(s[6 * 33], s[7 * 33]);
        *(GAS v4u*)(WT + (size_t)dst(n0 + n) * K + k0 + 8 * c) = o; }
    LDS_WAIT(); asm volatile("" ::: "memory");
}
struct DstIn { __device__ __forceinline__ int operator()(int n) const { return win_dst_row(n); } };
struct DstSlot { __device__ __forceinline__ int operator()(int n) const { return col2slot(n); } };

__device__ __forceinline__ void rms_row(Frame& F, const float* xrow, const float* g, bf16* orow, float* f32row) {
    const GAS f32x4* xr = (const GAS f32x4*)xrow + F.lane; const GAS f32x4* gr = (const GAS f32x4*)g + F.lane;
    f32x4 v[4]; float s = 0.f;
#pragma unroll
    for (int j = 0; j < 4; ++j) { v[j] = xr[64 * j]; s += (v[j].x * v[j].x + v[j].y * v[j].y) + (v[j].z * v[j].z + v[j].w * v[j].w); }
    const float rs = 1.0f / sqrtf(wave_sum(s) * (1.f / D) + RMS_EPS);
    GAS unsigned long long* o8 = (GAS unsigned long long*)orow + F.lane;
#pragma unroll
    for (int j = 0; j < 4; ++j) { const f32x4 y = (v[j] * rs) * gr[64 * j];
        o8[64 * j] = (unsigned long long)pk2(y.x, y.y) | ((unsigned long long)pk2(y.z, y.w) << 32);
        if (f32row) ((GAS f32x4*)f32row)[64 * j + F.lane] = y; }
}
__device__ __forceinline__ void p0_prologue(Frame& F) {
    LAS float* scr = (LAS float*)(F.lds + RING_OFF + F.wave * 16384);
    const int gw = blockIdx.x * NWAVES + F.wave, NGW = F.G * NWAVES;
    constexpr int I_IN = (D / 64) * (N_IN / 32), I_SQ = (D / 64) * (D / 32);
    constexpr int NITEMS = I_IN + 3 * I_SQ;
    for (int it = gw; it < NITEMS; it += NGW) {
        int r = it;
        if (r < I_IN) { p0_transpose_item(F.w_in, D, N_IN, F.Wt_in, scr, r, F.lane, DstIn()); continue; } r -= I_IN;
        if (r < I_SQ) { p0_transpose_item(F.w_out_c, D, D, F.Wt_oc, scr, r, F.lane, DstSlot()); continue; } r -= I_SQ;
        if (r < I_SQ) { p0_transpose_item(F.w_out_r, D, D, F.Wt_or, scr, r, F.lane, DstSlot()); continue; } r -= I_SQ;
        p0_transpose_item(F.w_o, D, D, F.Wt_o, scr, r, F.lane, DstSlot());
    }
    for (int m = gw; m < 256; m += NGW) { bf16* p = m < 128 ? F.Wt_in + (size_t)(32 * 256 + 128 + m) * D : F.H + (size_t)(NROW + 128 + (m - 128)) * D;
        GAS v4u* o = (GAS v4u*)p + F.lane; o[0] = (v4u){0u, 0u, 0u, 0u}; o[64] = (v4u){0u, 0u, 0u, 0u}; }
    for (int m = gw; m < NROW + DBATCH; m += NGW) {
        if (m < NPR) { const int t = m & (SEQ - 1); rms_row(F, F.x_prompt + (size_t)m * D, F.norm_g, F.H + (size_t)m * D, t == SEQ - 1 ? F.out + O_NSP + (size_t)(m >> 11) * D : nullptr); }
        else if (m < NROW) { const int rs = m - NPR; rms_row(F, F.x_sample + (size_t)rs * D, F.norm_g, F.H + (size_t)m * D, (rs & 3) == 3 ? F.out + O_NSS + (size_t)(rs >> 2) * D : nullptr); }
        else { const GAS f32x4* xr = (const GAS f32x4*)(F.state_shift + (size_t)(m - NROW) * D) + F.lane; GAS unsigned long long* o8 = (GAS unsigned long long*)(F.H + (size_t)m * D) + F.lane;
#pragma unroll
            for (int j = 0; j < 4; ++j) { const f32x4 y = xr[64 * j]; o8[64 * j] = (unsigned long long)pk2(y.x, y.y) | ((unsigned long long)pk2(y.z, y.w) << 32); } }
    }
}

__device__ __forceinline__ void p2_convmix(Frame& F) {
    bf16* YC = F.H;
    const int gt = blockIdx.x * (NWAVES * 64) + F.tid, NT = F.G * NWAVES * 64;
    for (int it = gt; it < NROW * 128; it += NT) {
        const int row = it >> 7, ch = (it & 127) * 8;
        int tis, b = 0; if (row < NPR) tis = row & (SEQ - 1); else { const int rs = row - NPR; tis = rs & 3; b = rs >> 2; }
        const bool smp = row >= NPR;
        f32x4 u0a, u0b, u1a, u1b, u2a, u2b, ga, gb;
        unpack8(*(const GAS v4u*)(F.U + (size_t)row * D + ch), u0a, u0b);
        unpack8(*(const GAS v4u*)(F.GC + (size_t)row * D + ch), ga, gb);
        if (tis >= 1) unpack8(*(const GAS v4u*)(F.U + (size_t)(row - 1) * D + ch), u1a, u1b);
        else if (smp) { const float* s = F.state_conv + ((size_t)b * 2 + 1) * D + ch; u1a = *(const GAS f32x4*)s; u1b = *(const GAS f32x4*)(s + 4); }
        else { u1a = (f32x4){0.f, 0.f, 0.f, 0.f}; u1b = u1a; }
        if (tis >= 2) unpack8(*(const GAS v4u*)(F.U + (size_t)(row - 2) * D + ch), u2a, u2b);
        else if (smp) { const float* s = F.state_conv + ((size_t)b * 2 + tis) * D + ch; u2a = *(const GAS f32x4*)s; u2b = *(const GAS f32x4*)(s + 4); }
        else { u2a = (f32x4){0.f, 0.f, 0.f, 0.f}; u2b = u2a; }
        const f32x4 c0a = *(const GAS f32x4*)(F.conv_w + ch), c0b = *(const GAS f32x4*)(F.conv_w + ch + 4);
        const f32x4 c1a = *(const GAS f32x4*)(F.conv_w + D + ch), c1b = *(const GAS f32x4*)(F.conv_w + D + ch + 4);
        const f32x4 c2a = *(const GAS f32x4*)(F.conv_w + 2 * D + ch), c2b = *(const GAS f32x4*)(F.conv_w + 2 * D + ch + 4);
        const f32x4 ya = ga * (c0a * u2a + c1a * u1a + c2a * u0a), yb = gb * (c0b * u2b + c1b * u1b + c2b * u0b);
        *(GAS v4u*)(YC + (size_t)row * D + ch) = pack8(ya, yb);
    }
}

constexpr int CH = 32;
constexpr int L_WUP = 0, L_AUP = 4096, L_D = 8192, L_KK = L_D + CH * 64, L_BE = L_KK + CH * 64, L_KH = L_BE + CH * 64, L_R = L_KH + CH * 64, L_V = L_R + CH * 64,
              L_Y = L_V + CH * 64, L_ZR = L_Y + CH * 64, L_TW = L_ZR + CH * 64, L_XA = L_TW + CH * 64, L_PREV = L_XA + CH * 64, L_BON = L_PREV + 2 * 6 * 64, L_END = L_BON + CH;
static_assert(L_END * 4 <= RING_BYTES, "scan LDS");
#define DPP_F(v, ctrl) __builtin_bit_cast(float, __builtin_amdgcn_update_dpp(0, __builtin_bit_cast(int, (v)), (ctrl), 0xF, 0xF, true))
__device__ __forceinline__ float red8(float v) {
    v += DPP_F(v, 0xB1);
    v += DPP_F(v, 0x4E);
    v += DPP_F(v, 0x141);
    return v;
}
__device__ __forceinline__ void scan_unit(Frame& F, int g0, int ntok, int h, int plast_row, const float* S0, float* Sout) {
    LAS float* L = (LAS float*)(F.lds + RING_OFF);
    const int tid = F.tid, lane = F.lane, w = F.wave, c = lane, col = h * 64 + c;
    for (int i = tid; i < 4096; i += NWAVES * 64) { const int r = i >> 6, cc = i & 63; L[L_WUP + i] = F.w_up[r * D + h * 64 + cc]; L[L_AUP + i] = F.a_up[r * D + h * 64 + cc]; }
    const float mu_r = F.mu[col], mu_k = F.mu[1024 + col], mu_v = F.mu[2048 + col], mu_wd = F.mu[3072 + c], mu_ad = F.mu[3136 + c], mu_zr = F.mu[3200 + col];
    const float w0c = F.w0[col], a0c = F.a0[col], kkc = F.k_k[col], kac = F.k_a[col], rkc = F.r_k[col], lnw = F.ln_w[col], lnb = F.ln_b[col];
    if (w == 0) {
        float p0 = 0.f, p1 = 0.f, p2 = 0.f, p3 = 0.f, p4 = 0.f, p5 = 0.f;
        if (plast_row >= 0) { const size_t o = (size_t)plast_row * D + col; p0 = bf2f(F.R[o]); p1 = bf2f(F.K[o]); p2 = bf2f(F.V[o]); p3 = bf2f(F.ZR[o]);
            p4 = bf2f(F.WA[(size_t)plast_row * 256 + c]); p5 = bf2f(F.WA[(size_t)plast_row * 256 + 64 + c]); }
        L[L_PREV + 0 * 64 + c] = p0; L[L_PREV + 1 * 64 + c] = p1; L[L_PREV + 2 * 64 + c] = p2; L[L_PREV + 3 * 64 + c] = p3; L[L_PREV + 4 * 64 + c] = p4; L[L_PREV + 5 * 64 + c] = p5;
    }
    const int srow = 8 * w + (lane >> 3), ks = lane & 7;
    float s[8];
    if (S0) { const f32x4 a = *(const GAS f32x4*)(S0 + srow * 64 + 8 * ks), b = *(const GAS f32x4*)(S0 + srow * 64 + 8 * ks + 4);
        s[0] = a.x; s[1] = a.y; s[2] = a.z; s[3] = a.w; s[4] = b.x; s[5] = b.y; s[6] = b.z; s[7] = b.w; }
    else {
#pragma unroll
        for (int i = 0; i < 8; ++i) s[i] = 0.f; }
    __syncthreads();
    int pb = 0;
    for (int t0 = 0; t0 < ntok; t0 += CH) {
        const int n = (ntok - t0) < CH ? (ntok - t0) : CH;
        const bool act = 4 * w < n;
        float xr_[4], xk_[4], xv_[4], xz_[4];
        if (act) {
            float pr, pk, pv, pz, pw, pa;
            if (w == 0) { const LAS float* P = L + L_PREV + pb * 384; pr = P[c]; pk = P[64 + c]; pv = P[128 + c]; pz = P[192 + c]; pw = P[256 + c]; pa = P[320 + c]; }
            else { const int prow = g0 + t0 + 4 * w - 1; const size_t o = (size_t)prow * D + col; pr = bf2f(F.R[o]); pk = bf2f(F.K[o]); pv = bf2f(F.V[o]); pz = bf2f(F.ZR[o]);
                pw = bf2f(F.WA[(size_t)prow * 256 + c]); pa = bf2f(F.WA[(size_t)prow * 256 + 64 + c]); }
#pragma unroll
            for (int i = 0; i < 4; ++i) { const int t = 4 * w + i, grow = g0 + t0 + t; const size_t o = (size_t)grow * D + col;
                const float r = bf2f(F.R[o]), k = bf2f(F.K[o]), v = bf2f(F.V[o]), z = bf2f(F.ZR[o]), wd = bf2f(F.WA[(size_t)grow * 256 + c]), ad = bf2f(F.WA[(size_t)grow * 256 + 64 + c]);
                xr_[i] = r + (pr - r) * mu_r; xk_[i] = k + (pk - k) * mu_k; xv_[i] = v + (pv - v) * mu_v; xz_[i] = z + (pz - z) * mu_zr;
                L[L_TW + t * 64 + c] = tanhf(wd + (pw - wd) * mu_wd); L[L_XA + t * 64 + c] = ad + (pa - ad) * mu_ad;
                pr = r; pk = k; pv = v; pz = z; pw = wd; pa = ad;
                if (t == n - 1) { LAS float* P = L + L_PREV + (pb ^ 1) * 384; P[c] = r; P[64 + c] = k; P[128 + c] = v; P[192 + c] = z; P[256 + c] = wd; P[320 + c] = ad; } }
        }
        __syncthreads();
        if (act) {
            float wl[4], al[4];
#pragma unroll
            for (int i = 0; i < 4; ++i) { wl[i] = w0c; al[i] = a0c; }
#pragma unroll 4
            for (int r4 = 0; r4 < 16; ++r4) {
                f32x4 tw[4], xa[4];
#pragma unroll
                for (int i = 0; i < 4; ++i) { tw[i] = *(const LAS f32x4*)(L + L_TW + (4 * w + i) * 64 + 4 * r4); xa[i] = *(const LAS f32x4*)(L + L_XA + (4 * w + i) * 64 + 4 * r4); }
#pragma unroll
                for (int q = 0; q < 4; ++q) { const float wu = L[L_WUP + (4 * r4 + q) * 64 + c], au = L[L_AUP + (4 * r4 + q) * 64 + c];
#pragma unroll
                    for (int i = 0; i < 4; ++i) { wl[i] += tw[i][q] * wu; al[i] += xa[i][q] * au; } }
            }
#pragma unroll
            for (int i = 0; i < 4; ++i) { const int t = 4 * w + i;
                const float dec = __expf(-0.6065306597126334f * sigmoidf_(wl[i])), a = sigmoidf_(al[i]);
                const float kkv = xk_[i] * kkc, nrm = sqrtf(wave_sum(kkv * kkv)), kk = kkv / fmaxf(nrm, 1e-12f);
                const float kh = xk_[i] * (1.0f + (a - 1.0f) * kac), bon = wave_sum(xr_[i] * kh * rkc);
                L[L_D + t * 64 + c] = dec; L[L_KK + t * 64 + c] = kk; L[L_BE + t * 64 + c] = kk * a; L[L_KH + t * 64 + c] = kh; L[L_R + t * 64 + c] = xr_[i]; L[L_V + t * 64 + c] = xv_[i];
                L[L_ZR + t * 64 + c] = xz_[i] * sigmoidf_(xz_[i]); if (lane == 0) L[L_BON + t] = bon; }
        }
        __syncthreads();
#pragma unroll 2
        for (int t = 0; t < n; ++t) {
            const LAS float* B = L + t * 64 + 8 * ks;
            const f32x4 k0 = *(const LAS f32x4*)(B + L_KK), k1 = *(const LAS f32x4*)(B + L_KK + 4), d0 = *(const LAS f32x4*)(B + L_D), d1 = *(const LAS f32x4*)(B + L_D + 4);
            const f32x4 b0 = *(const LAS f32x4*)(B + L_BE), b1 = *(const LAS f32x4*)(B + L_BE + 4), h0 = *(const LAS f32x4*)(B + L_KH), h1 = *(const LAS f32x4*)(B + L_KH + 4);
            const f32x4 r0 = *(const LAS f32x4*)(B + L_R), r1 = *(const LAS f32x4*)(B + L_R + 4);
            const float vv = L[L_V + t * 64 + srow];
            float p = (s[0] * k0.x + s[1] * k0.y) + (s[2] * k0.z + s[3] * k0.w) + (s[4] * k1.x + s[5] * k1.y) + (s[6] * k1.z + s[7] * k1.w);
            const float sa = -red8(p);
            s[0] = s[0] * d0.x + (sa * b0.x + vv * h0.x); s[1] = s[1] * d0.y + (sa * b0.y + vv * h0.y); s[2] = s[2] * d0.z + (sa * b0.z + vv * h0.z); s[3] = s[3] * d0.w + (sa * b0.w + vv * h0.w);
            s[4] = s[4] * d1.x + (sa * b1.x + vv * h1.x); s[5] = s[5] * d1.y + (sa * b1.y + vv * h1.y); s[6] = s[6] * d1.z + (sa * b1.z + vv * h1.z); s[7] = s[7] * d1.w + (sa * b1.w + vv * h1.w);
            float q = (s[0] * r0.x + s[1] * r0.y) + (s[2] * r0.z + s[3] * r0.w) + (s[4] * r1.x + s[5] * r1.y) + (s[6] * r1.z + s[7] * r1.w);
            q = red8(q);
            if (ks == 0) L[L_Y + t * 64 + srow] = q;
        }
        __syncthreads();
        if (act) {
#pragma unroll
            for (int i = 0; i < 4; ++i) { const int t = 4 * w + i;
                const float y = L[L_Y + t * 64 + c], mean = wave_sum(y) * (1.f / 64.f), dv = y - mean, var = wave_sum(dv * dv) * (1.f / 64.f);
                const float yn = dv * (1.0f / sqrtf(var + GN_EPS)) * lnw + lnb;
                const float o = (yn + L[L_BON + t] * L[L_V + t * 64 + c]) * L[L_ZR + t * 64 + c];
                F.R[(size_t)(g0 + t0 + t) * D + col] = (bf16)f2bf(o); }
        }
        pb ^= 1;
    }
    { f32x4 a, b; a.x = s[0]; a.y = s[1]; a.z = s[2]; a.w = s[3]; b.x = s[4]; b.y = s[5]; b.z = s[6]; b.w = s[7];
      *(GAS f32x4*)(Sout + srow * 64 + 8 * ks) = a; *(GAS f32x4*)(Sout + srow * 64 + 8 * ks + 4) = b; }
    __syncthreads();
}
__device__ __forceinline__ void p2_scan(Frame& F) {
    for (int su = blockIdx.x; su < DBATCH * NH; su += F.G) { const int b = su >> 4, h = su & 15;
        scan_unit(F, NPR + 4 * b, 4, h, NROW + b, F.state_rwkv + (size_t)su * 4096, F.out + O_NRS + (size_t)su * 4096); }
    for (int pu = blockIdx.x; pu < 8 * NH; pu += F.G) { const int b = pu >> 4, h = pu & 15;
        scan_unit(F, b * SEQ, SEQ, h, -1, nullptr, F.out + O_NRP + (size_t)pu * 4096); }
}

__device__ __forceinline__ void p3_final_norm(Frame& F) {
    const int gw = blockIdx.x * NWAVES + F.wave, NGW = F.G * NWAVES;
    for (int m = gw; m < NROW; m += NGW) {
        GAS f32x4* xr = (GAS f32x4*)(F.out + O_Y + (size_t)m * D) + F.lane; const GAS f32x4* gr = (const GAS f32x4*)F.final_g + F.lane;
        const GAS f32x4* st = (const GAS f32x4*)(F.STATS + (size_t)m * 16);
        const f32x4 s0 = st[0], s1 = st[1], s2 = st[2], s3 = st[3];
        const float ss = ((s0.x + s0.y) + (s0.z + s0.w)) + ((s1.x + s1.y) + (s1.z + s1.w)) + ((s2.x + s2.y) + (s2.z + s2.w)) + ((s3.x + s3.y) + (s3.z + s3.w));
        const float rs = 1.0f / sqrtf(ss * (1.f / D) + RMS_EPS);
#pragma unroll
        for (int j = 0; j < 4; ++j) { const f32x4 v = xr[64 * j]; xr[64 * j] = (v * rs) * gr[64 * j]; }
    }
}

struct Args { const float* in[22]; float* out; unsigned char* ws; int ph_lo, ph_hi; };
__global__ void __launch_bounds__(NWAVES * 64, 2) mk_fwd(Args args) {
    extern __shared__ __attribute__((aligned(16))) unsigned char lds[];
    Frame F;
    F.lds = (LAS unsigned char*)lds;
    F.MISC = (volatile LAS unsigned*)(F.lds + MISC_OFF);
    F.tid = threadIdx.x; F.lane = F.tid & 63; F.wave = __builtin_amdgcn_readfirstlane(F.tid >> 6);
    F.G = gridDim.x;
    unsigned char* ws = args.ws;
    F.ctl = (gu32*)(ws + WS_CTL);
    F.x_prompt = args.in[0]; F.x_sample = args.in[1]; F.state_conv = args.in[2]; F.state_shift = args.in[3]; F.state_rwkv = args.in[4]; F.norm_g = args.in[5]; F.w_in = args.in[6];
    F.conv_w = args.in[7]; F.mu = args.in[8]; F.w0 = args.in[9]; F.w_up = args.in[10]; F.a0 = args.in[11]; F.a_up = args.in[12]; F.k_k = args.in[13]; F.k_a = args.in[14]; F.r_k = args.in[15];
    F.ln_w = args.in[16]; F.ln_b = args.in[17]; F.w_out_c = args.in[18]; F.w_out_r = args.in[19]; F.w_o = args.in[20]; F.final_g = args.in[21];
    F.out = args.out;
    F.Wt_in = (bf16*)(args.out + O_NRS); F.SGCp = (bf16*)(args.out + O_Y); F.SGRp = F.SGCp + (size_t)NPR * D;
    F.Wt_oc = (bf16*)(ws + WS_WOC); F.Wt_or = (bf16*)(ws + WS_WOR); F.Wt_o = (bf16*)(ws + WS_WO);
    F.STATS = (float*)(ws + WS_STATS); F.SGCs = (bf16*)(ws + WS_SGS); F.SGRs = F.SGCs + (size_t)NSR * D;
    F.H = (bf16*)(ws + WS_H); F.U = (bf16*)(ws + WS_U); F.GC = (bf16*)(ws + WS_GC); F.T1 = (float*)(ws + WS_U);
    F.R = (bf16*)(ws + WS_R); F.K = (bf16*)(ws + WS_K); F.V = (bf16*)(ws + WS_V); F.ZR = (bf16*)(ws + WS_ZR); F.WA = (bf16*)(ws + WS_WA);
    for (int u = F.tid; u < (LDS_BYTES - LDSCTL_OFF) / 4; u += NWAVES * 64) ((LAS unsigned*)(F.lds + LDSCTL_OFF))[u] = 0u;
    __syncthreads();
    XcdBarrier bar; bar.bar = (unsigned*)(F.ctl + CW_BAR); bar.x = 0; bar.st = nullptr;
    if (N_LAUNCHES == 1) bar = xcd_barrier_post((unsigned*)(F.ctl + CW_BAR), F.MISC + 8);
#define GRID_BAR() do { if (N_LAUNCHES == 1) xcd_barrier(bar); } while (0)
    const int lo = args.ph_lo, hi = args.ph_hi;
#define IN(k) (lo <= (k) && (k) < hi)
#define BOTH(k) (IN(k) && IN((k) + 1))

    if (IN(0)) { p0_prologue(F); if (BOTH(0)) GRID_BAR(); }

    if (IN(1)) {
        pg8::Gemm g{F.H, F.Wt_in, NROWP, NT_IN * 256, D}; P1Order S{F.G, (int)blockIdx.x};
        EpiP1 E{F.U, F.GC, F.R, F.WA, F.SGCp, F.SGCs, F.out + O_NCP, F.out + O_NCS};
        pg8::gemm_phase<EpiP1, P1Order, true, true>(F.lds + RING_OFF, g, S, E);
        if (BOTH(1)) GRID_BAR();
    }

    if (IN(2)) { p2_convmix(F); p2_scan(F); if (BOTH(2)) GRID_BAR(); }

    if (IN(3)) {
        pg8::Gemm g{F.H, F.Wt_oc, NROW, D, D}; pg8::StaticOrder S; S.init(NROW, D, F.G, (int)blockIdx.x);
        EpiT1 E{F.T1, F.SGCp, F.SGCs};
        pg8::gemm_phase<EpiT1, pg8::StaticOrder, true, true>(F.lds + RING_OFF, g, S, E);
        if (BOTH(3)) GRID_BAR();
    }
    if (IN(4)) {
        pg8::Gemm g{F.R, F.Wt_or, NROW, D, D}; pg8::StaticOrder S; S.init(NROW, D, F.G, (int)blockIdx.x);
        EpiM E{F.T1, F.K, F.SGRp, F.SGRs};
        pg8::gemm_phase<EpiM, pg8::StaticOrder, true, true>(F.lds + RING_OFF, g, S, E);
        if (BOTH(4)) GRID_BAR();
    }
    if (IN(5)) {
        pg8::Gemm g{F.K, F.Wt_o, NROW, D, D}; pg8::StaticOrder S; S.init(NROW, D, F.G, (int)blockIdx.x);
        EpiXo E{F.x_prompt, F.x_sample, F.out + O_Y, F.STATS};
        pg8::gemm_phase<EpiXo, pg8::StaticOrder, true, true>(F.lds + RING_OFF, g, S, E);
        if (BOTH(5)) GRID_BAR();
    }
    if (IN(6)) { p3_final_norm(F); }
#undef IN
#undef BOTH
}

extern "C" void kernel_launch(void* const* d_in, const int* in_sizes, int n_in, void* d_out, int out_size, void* d_ws, size_t ws_size, hipStream_t stream) {
    static int grid = 0;
    if (grid == 0) {
        if (n_in != 22 || in_sizes[0] != NPR * D || out_size != (int)O_END || ws_size < WS_END) {
            fprintf(stderr, "kernel_launch: unexpected shapes: n_in %d in0 %d out %d ws %zu; nothing launched\n", n_in, n_in > 0 ? in_sizes[0] : -1, out_size, ws_size); grid = -1; return; }
        int dev = 0, cus = 0, per_cu = 0;
        if (hipGetDevice(&dev) != hipSuccess || hipDeviceGetAttribute(&cus, hipDeviceAttributeMultiprocessorCount, dev) != hipSuccess) { fprintf(stderr, "kernel_launch: device query failed\n"); grid = -1; return; }
        if (hipFuncSetAttribute((const void*)mk_fwd, hipFuncAttributeMaxDynamicSharedMemorySize, LDS_BYTES) != hipSuccess) { fprintf(stderr, "kernel_launch: hipFuncSetAttribute failed\n"); grid = -1; return; }
        if (hipOccupancyMaxActiveBlocksPerMultiprocessor(&per_cu, (const void*)mk_fwd, NWAVES * 64, LDS_BYTES) != hipSuccess || per_cu < 1) { fprintf(stderr, "kernel_launch: occupancy query reports %d workgroups per CU\n", per_cu); per_cu = 1; }
        (void)hipGetLastError();
        grid = cus;
        if (grid > 256) grid = 256;
    }
    if (grid < 0) return;
    (void)hipMemsetAsync((char*)d_ws + WS_CTL, 0, CTL_ZERO_BYTES, stream);
    Args a{};
    for (int i = 0; i < 22; ++i) a.in[i] = (const float*)d_in[i];
    a.out = (float*)d_out; a.ws = (unsigned char*)d_ws;
    if (N_LAUNCHES == 1) { a.ph_lo = 0; a.ph_hi = N_PHASES; hipLaunchKernelGGL(mk_fwd, dim3(grid), dim3(NWAVES * 64), LDS_BYTES, stream, a); }
    else for (int li = 0; li < N_PHASES; ++li) { a.ph_lo = li; a.ph_hi = li + 1; hipLaunchKernelGGL(mk_fwd, dim3(grid), dim3(NWAVES * 64), LDS_BYTES, stream, a); }
}
```

```cpp
#include <hip/hip_runtime.h>
#include <cstdio>
#include <cstdint>
namespace pg8 {
#define PG8_LAS __attribute__((address_space(3)))
typedef unsigned short bf16_t;
typedef short bf16x8 __attribute__((ext_vector_type(8)));
typedef float f32x4 __attribute__((ext_vector_type(4)));
typedef unsigned u32x4 __attribute__((ext_vector_type(4)));
constexpr int BM = 256, BK = 64, HALF = 128, HTB = HALF * BK * 2  , STAGE_BYTES = 8 * HTB, NXCD = 8, WGM = 8;

__host__ __device__ __forceinline__ int lds_byte(int r, int c) { const int st = (r >> 4) * 2 + (c >> 5), rr = r & 15, cc = c & 31, ob = rr * 64 + cc * 2; return st * 1024 + (ob ^ (((ob >> 9) & 1) << 5)); }
__host__ __device__ __forceinline__ void stage_rc(int b, int& R, int& C) { const int st = b / 1024, sb = b % 1024, swz = sb ^ (((sb >> 9) & 1) << 5); R = (st >> 1) * 16 + swz / 64; C = (st & 1) * 32 + (swz % 64) / 2; }
__host__ __device__ __forceinline__ int perm32(int rho) { const int n = rho >> 4, i = rho & 15; return 8 * (i >> 2) + 4 * n + (i & 3); }

struct Unit { int pm, pn; };
struct Gemm { const bf16_t* A; const bf16_t* Bt; int M, N, K; };

struct StaticOrder {
    int nM, nN, nwg, G, c;
    __host__ __device__ void init(int M, int N, int G_, int c_) { nM = M / BM; nN = N / BM; nwg = nM * nN; G = G_; c = c_; }
    __host__ __device__ bool next(int i, Unit& u) const {
        const long L = (long)i * G + c; if (L >= nwg) return false;
        int wgid = (int)L; { const int q = nwg / NXCD, r = nwg % NXCD, xcd = wgid % NXCD, off = wgid / NXCD; wgid = (xcd < r ? xcd * (q + 1) : r * (q + 1) + (xcd - r) * q) + off; }
        const int nig = WGM * nN, gid = wgid / nig, fm = gid * WGM, gsz = (nM - fm) < WGM ? (nM - fm) : WGM;
        u.pm = fm + ((wgid % nig) % gsz); u.pn = (wgid % nig) / gsz; return true;
    }
    __device__ __forceinline__ void a_ready(const Unit&) const {}
    __device__ __forceinline__ void done(const Unit&) const {}
};

template <class Epi, class Sched, bool ALIGN_EPI = false, bool SP2 = false>
__device__ __forceinline__ void gemm_phase(PG8_LAS unsigned char* lds, const Gemm g, const Sched& S, const Epi& E) {
    const int tid = threadIdx.x, wid = __builtin_amdgcn_readfirstlane(tid >> 6), lane = tid & 63, wr = wid >> 2, wc = wid & 3, fr = lane & 15, fq = lane >> 4;
    const int K = g.K, nt = K / BK;
    unsigned voffA[2], voffB[2];
#pragma unroll
    for (int i = 0; i < 2; ++i) { int R, C; stage_rc(tid * 16 + i * 8192, R, C); const int Rb = Epi::PERM ? ((R & ~31) + perm32(R & 31)) : R;
        voffA[i] = (unsigned)(R * K + C) * 2u; voffB[i] = (unsigned)(Rb * K + C) * 2u; }
    const size_t kstep = (size_t)(BK * 2);
    const size_t hstep = (size_t)HALF * K * 2;
    const size_t tstep = 2 * hstep;
    const unsigned ldsw = (unsigned)wid * 1024u;
    const int aoff = lds_byte(wr * 64 + fr, fq * 8), boff = lds_byte(wc * 32 + fr, fq * 8);
#define PG8_SA(b, h) (((b) * 2 + (h)) * HTB)
#define PG8_SB(b, h) ((4 + (b) * 2 + (h)) * HTB)
#define PG8_STAGE(bufoff, gbase, voff) do { _Pragma("unroll") for (int _i = 0; _i < 2; ++_i) \
        __builtin_amdgcn_global_load_lds((const unsigned*)((const char*)(gbase) + (voff)[_i]), (PG8_LAS unsigned*)(lds + (bufoff) + ldsw + _i * 8192), 16, 0, 0); } while (0)
#define PG8_LDA(dst, b, h) do { _Pragma("unroll") for (int m = 0; m < 4; ++m) _Pragma("unroll") for (int k = 0; k < 2; ++k) dst[m][k] = *(const PG8_LAS bf16x8*)(lds + PG8_SA(b, h) + aoff + m * 2048 + k * 1024); } while (0)
#define PG8_LDB(dst, b, h) do { _Pragma("unroll") for (int n = 0; n < 2; ++n) _Pragma("unroll") for (int k = 0; k < 2; ++k) dst[n][k] = *(const PG8_LAS bf16x8*)(lds + PG8_SB(b, h) + boff + n * 2048 + k * 1024); } while (0)
#define PG8_MMA(ai, bj, At, Bt) do { __builtin_amdgcn_s_setprio(1); _Pragma("unroll") for (int m = 0; m < 4; ++m) _Pragma("unroll") for (int n = 0; n < 2; ++n) _Pragma("unroll") for (int k = 0; k < 2; ++k) \
        acc[ai][bj][m][n] = __builtin_amdgcn_mfma_f32_16x16x32_bf16(Bt[n][k], At[m][k], acc[ai][bj][m][n], 0, 0, 0); __builtin_amdgcn_s_setprio(0); } while (0)
#define PG8_WAIT_V(n) asm volatile("s_waitcnt vmcnt(" #n ")" ::: "memory")
#define PG8_WAIT_L(n) asm volatile("s_waitcnt lgkmcnt(" #n ")" ::: "memory")
#define PG8_BAR __builtin_amdgcn_s_barrier()
#define PG8_SCHED __builtin_amdgcn_sched_barrier(0)
    Unit cur, nxt; int ui = 0;
    if (!S.next(0, cur)) return;
    f32x4 acc[2][2][4][2];
#pragma unroll
    for (int a = 0; a < 2; ++a)
#pragma unroll
        for (int b = 0; b < 2; ++b)
#pragma unroll
            for (int m = 0; m < 4; ++m)
#pragma unroll
                for (int n = 0; n < 2; ++n) acc[a][b][m][n] = (f32x4){0.f, 0.f, 0.f, 0.f};
    bf16x8 At[4][2], B0[2][2], B1[2][2];
    const char* cA = (const char*)g.A + (size_t)cur.pm * tstep; const char* cB = (const char*)g.Bt + (size_t)cur.pn * tstep;
    S.a_ready(cur);
    if constexpr (SP2) {
        PG8_STAGE(PG8_SB(0, 0), cB, voffB); PG8_STAGE(PG8_SB(0, 1), cB + hstep, voffB); PG8_STAGE(PG8_SA(0, 0), cA, voffA); PG8_STAGE(PG8_SA(0, 1), cA + hstep, voffA);
        if (wr == 1) PG8_BAR;
        PG8_WAIT_V(2); PG8_BAR;
        PG8_STAGE(PG8_SB(1, 0), cB + kstep, voffB); PG8_STAGE(PG8_SA(1, 0), cA + kstep, voffA); PG8_STAGE(PG8_SB(1, 1), cB + hstep + kstep, voffB);
        PG8_WAIT_V(6); PG8_BAR;
    } else {
        PG8_STAGE(PG8_SB(0, 0), cB, voffB); PG8_STAGE(PG8_SA(0, 0), cA, voffA); PG8_STAGE(PG8_SB(0, 1), cB + hstep, voffB); PG8_STAGE(PG8_SA(0, 1), cA + hstep, voffA);
        if (wr == 1) PG8_BAR;
        PG8_WAIT_V(4); PG8_BAR;
        PG8_STAGE(PG8_SB(1, 0), cB + kstep, voffB); PG8_STAGE(PG8_SA(1, 0), cA + kstep, voffA); PG8_STAGE(PG8_SB(1, 1), cB + hstep + kstep, voffB);
        PG8_WAIT_V(6); PG8_BAR;
    }
    for (;;) {
        const bool has_next = S.next(ui + 1, nxt);
        const char* nA = has_next ? (const char*)g.A + (size_t)nxt.pm * tstep : cA; const char* nB = has_next ? (const char*)g.Bt + (size_t)nxt.pn * tstep : cB;
        for (int t = 0; t < nt; t += 2) {
            const bool last = (t == nt - 2);
            const char* a1 = cA + (size_t)(t + 1) * kstep;
            const char* a2 = last ? nA : cA + (size_t)(t + 2) * kstep; const char* b2 = last ? nB : cB + (size_t)(t + 2) * kstep;
            const char* a3 = a2 + kstep; const char* b3 = b2 + kstep;
            if (last && has_next) S.a_ready(nxt);
            if constexpr (SP2) {
            PG8_LDB(B0, 0, 0); PG8_LDB(B1, 0, 1); PG8_SCHED; PG8_LDA(At, 0, 0); PG8_STAGE(PG8_SA(1, 1), a1 + hstep, voffA);
            PG8_WAIT_V(8); PG8_WAIT_L(0); PG8_BAR; PG8_MMA(0, 0, At, B0); PG8_MMA(0, 1, At, B1); PG8_BAR; PG8_SCHED;
            PG8_LDA(At, 0, 1); PG8_STAGE(PG8_SB(0, 0), b2, voffB); PG8_STAGE(PG8_SB(0, 1), b2 + hstep, voffB); PG8_STAGE(PG8_SA(0, 0), a2, voffA);
            PG8_WAIT_V(8); PG8_WAIT_L(0); PG8_BAR; PG8_MMA(1, 0, At, B0); PG8_MMA(1, 1, At, B1); PG8_BAR; PG8_SCHED;
            PG8_LDB(B0, 1, 0); PG8_LDB(B1, 1, 1); PG8_SCHED; PG8_LDA(At, 1, 0); PG8_STAGE(PG8_SA(0, 1), a2 + hstep, voffA);
            PG8_WAIT_V(8); PG8_WAIT_L(0); PG8_BAR; PG8_MMA(0, 0, At, B0); PG8_MMA(0, 1, At, B1); PG8_BAR; PG8_SCHED;
            PG8_LDA(At, 1, 1); PG8_STAGE(PG8_SB(1, 0), b3, voffB); PG8_STAGE(PG8_SB(1, 1), b3 + hstep, voffB); PG8_STAGE(PG8_SA(1, 0), a3, voffA);
            PG8_WAIT_V(8); PG8_WAIT_L(0); PG8_BAR; PG8_MMA(1, 0, At, B0); PG8_MMA(1, 1, At, B1); PG8_BAR; PG8_SCHED;
            } else {
            PG8_LDB(B0, 0, 0); PG8_SCHED; PG8_LDA(At, 0, 0); PG8_STAGE(PG8_SA(1, 1), a1 + hstep, voffA);
            PG8_WAIT_L(8); PG8_BAR; PG8_WAIT_L(0); PG8_MMA(0, 0, At, B0); PG8_BAR; PG8_SCHED;
            PG8_LDB(B1, 0, 1); PG8_STAGE(PG8_SB(0, 0), b2, voffB);
            PG8_BAR; PG8_WAIT_L(0); PG8_MMA(0, 1, At, B1); PG8_BAR;
            PG8_LDA(At, 0, 1); PG8_STAGE(PG8_SA(0, 0), a2, voffA);
            PG8_BAR; PG8_WAIT_L(0); PG8_MMA(1, 0, At, B0); PG8_BAR; PG8_SCHED;
            PG8_STAGE(PG8_SB(0, 1), b2 + hstep, voffB);
            PG8_WAIT_V(6); PG8_BAR; PG8_MMA(1, 1, At, B1); PG8_BAR;
            PG8_LDB(B0, 1, 0); PG8_SCHED; PG8_LDA(At, 1, 0); PG8_STAGE(PG8_SA(0, 1), a2 + hstep, voffA);
            PG8_WAIT_L(8); PG8_BAR; PG8_WAIT_L(0); PG8_MMA(0, 0, At, B0); PG8_BAR; PG8_SCHED;
            PG8_LDB(B1, 1, 1); PG8_STAGE(PG8_SB(1, 0), b3, voffB);
            PG8_BAR; PG8_WAIT_L(0); PG8_MMA(0, 1, At, B1); PG8_BAR;
            PG8_LDA(At, 1, 1); PG8_STAGE(PG8_SA(1, 0), a3, voffA);
            PG8_BAR; PG8_WAIT_L(0); PG8_MMA(1, 0, At, B0); PG8_BAR; PG8_SCHED;
            PG8_STAGE(PG8_SB(1, 1), b3 + hstep, voffB);
            PG8_WAIT_V(6); PG8_BAR; PG8_MMA(1, 1, At, B1); PG8_BAR;
            }
        }
        if constexpr (ALIGN_EPI) { if (wr == 0) PG8_BAR; }
        if constexpr (!Epi::AFTER_DRAIN) { E(acc, cur, wr, wc, fr, fq); S.done(cur); }
        if (!has_next) break;
#pragma unroll
        for (int a = 0; a < 2; ++a)
#pragma unroll
            for (int b = 0; b < 2; ++b)
#pragma unroll
                for (int m = 0; m < 4; ++m)
#pragma unroll
                    for (int n = 0; n < 2; ++n) acc[a][b][m][n] = (f32x4){0.f, 0.f, 0.f, 0.f};
        cur = nxt; cA = nA; cB = nB; ++ui;
        if constexpr (ALIGN_EPI) { if (wr == 1) PG8_BAR; }
    }
    PG8_WAIT_V(0);
    if constexpr (!ALIGN_EPI) { if (wr == 0) PG8_BAR; }
    PG8_BAR;
    if constexpr (Epi::AFTER_DRAIN) { E.fused(acc, cur, wr, wc, fr, fq, lds, wid, lane); S.done(cur); }
#undef PG8_SA
#undef PG8_SB
#undef PG8_STAGE
#undef PG8_LDA
#undef PG8_LDB
#undef PG8_MMA
#undef PG8_WAIT_V
#undef PG8_WAIT_L
#undef PG8_BAR
#undef PG8_SCHED
}
}
#define GAS __attribute__((address_space(1)))
#define LAS __attribute__((address_space(3)))
typedef unsigned short bf16;
typedef unsigned v4u __attribute__((ext_vector_type(4)));
typedef float f32x4 __attribute__((ext_vector_type(4)));
typedef short bf16x8 __attribute__((ext_vector_type(8)));
typedef GAS unsigned gu32;
typedef GAS unsigned long long gu64;
#define RLX_AGENT __ATOMIC_RELAXED, __HIP_MEMORY_SCOPE_AGENT
#define LDS_WAIT() asm volatile("s_waitcnt lgkmcnt(0)" ::: "memory")
#define VM_WAIT() asm volatile("s_waitcnt vmcnt(0)" ::: "memory")
__device__ __forceinline__ unsigned long long rt() { return __builtin_amdgcn_s_memrealtime(); }
__device__ __forceinline__ unsigned f2bf(float f) { unsigned u = __builtin_bit_cast(unsigned, f); return (u + 0x7fffu + ((u >> 16) & 1u)) >> 16; }
__device__ __forceinline__ unsigned pk2(float lo, float hi) { return f2bf(lo) | (f2bf(hi) << 16); }

#define XB_TMO      128
#define XB_XCNT(j)  (256  + 64 * (j))
#define XB_XSUB(j)  (1280 + 64 * (j))
#define XB_XGEN(j)  (2304 + 64 * (j))
#define XB_TOP      3328
#define XB_TOPGEN   3392
#define XCD_BAR_WORDS 3456
#define XB_SPIN_CAP (1u << 18)

__device__ __forceinline__ unsigned xb_ld(unsigned* p)              { return __hip_atomic_load(p, __ATOMIC_RELAXED, __HIP_MEMORY_SCOPE_AGENT); }
__device__ __forceinline__ unsigned xb_add(unsigned* p, unsigned v) { return __hip_atomic_fetch_add(p, v, __ATOMIC_RELAXED, __HIP_MEMORY_SCOPE_AGENT); }
__device__ __forceinline__ unsigned xb_xcc_id() { return (unsigned)__builtin_amdgcn_s_getreg((3 << 11) | 20) & 0xFu; }
#define XB_SPIN(cond, bar) do { unsigned _sp = 0; while (cond) { __builtin_amdgcn_s_sleep(1); \
    if ((++_sp & 255u) == 0u) { if (xb_ld(&(bar)[XB_TMO])) break; if (_sp > XB_SPIN_CAP) { atomicAdd(&(bar)[XB_TMO], 1u); break; } } } } while (0)

struct XcdBarrier {
    unsigned* bar; unsigned x;
    volatile LAS unsigned* st;
};

__device__ __forceinline__ XcdBarrier xcd_barrier_post(unsigned* bar, volatile LAS unsigned* st) {
    XcdBarrier b; b.bar = bar; b.x = xb_xcc_id(); b.st = st;
    if (threadIdx.x == 0) (void)xb_add(&bar[XB_XCNT(b.x)], 1u);
    return b;
}
__device__ __forceinline__ void xcd_barrier_complete(unsigned* bar, unsigned x, unsigned& nloc, unsigned& nx) {
    const unsigned G = gridDim.x * gridDim.y * gridDim.z;
    unsigned sum, cnt, mine, sp = 0u;
    for (;;) {
        sum = 0u; cnt = 0u; mine = 0u;
#pragma unroll
        for (unsigned j = 0; j < 16; ++j) { const unsigned c = xb_ld(&bar[XB_XCNT(j)]); sum += c; cnt += (c > 0u) ? 1u : 0u; mine = (j == x) ? c : mine; }
        if (sum == G) break;
        __builtin_amdgcn_s_sleep(1);
        if ((++sp & 255u) == 0u) { if (xb_ld(&bar[XB_TMO])) break; if (sp > XB_SPIN_CAP) { atomicAdd(&bar[XB_TMO], 1u); break; } }
    }
    nloc = mine > 0u ? mine : 1u; nx = cnt > 0u ? cnt : 1u;
}

__device__ __forceinline__ void xcd_barrier(const XcdBarrier& b) {
    asm volatile("s_waitcnt vmcnt(0)" ::: "memory");
    __syncthreads();
    if (threadIdx.x == 0) {
        unsigned* bar = b.bar;
        __builtin_amdgcn_s_waitcnt(0);
        unsigned nloc = b.st[0], nx = b.st[1];
        if (nloc == 0u) { xcd_barrier_complete(bar, b.x, nloc, nx); b.st[0] = nloc; b.st[1] = nx; }
        const unsigned old = xb_add(&bar[XB_XSUB(b.x)], 1u);
        const unsigned gen = old / nloc;
        if (old + 1u == (gen + 1u) * nloc) {
            __builtin_amdgcn_fence(__ATOMIC_RELEASE, "agent");
            asm volatile("s_waitcnt vmcnt(0)" ::: "memory");
            const unsigned og = xb_add(&bar[XB_TOP], 1u);
            const unsigned tg = og / nx;
            if (og + 1u == (tg + 1u) * nx) xb_add(&bar[XB_TOPGEN], 1u);
            else XB_SPIN(xb_ld(&bar[XB_TOPGEN]) == tg, bar);
            __builtin_amdgcn_fence(__ATOMIC_ACQUIRE, "agent");
            xb_add(&bar[XB_XGEN(b.x)], 1u);
            asm volatile("s_waitcnt vmcnt(0)" ::: "memory");
        } else {
            XB_SPIN(xb_ld(&bar[XB_XGEN(b.x)]) == gen, bar);
            __builtin_amdgcn_fence(__ATOMIC_ACQUIRE, "agent");
            asm volatile("s_waitcnt vmcnt(0)" ::: "memory");
        }
    }
    __syncthreads();
}

constexpr int NWAVES = 8;
constexpr int D = 1024, NPR = 16384, NSR = 512, NROW = NPR + NSR, NROWP = 17152;
constexpr int SEQ = 2048, DBATCH = 128, NH = 16;
constexpr int N_IN = 10368, NT_IN = 41;
constexpr float RMS_EPS = 1e-6f, GN_EPS = 64e-5f;
#ifndef MK_N_LAUNCHES
#define MK_N_LAUNCHES 1
#endif
constexpr int N_PHASES = 7;
#ifndef PROBE_DUP
#define PROBE_DUP 0
#endif
constexpr int N_LAUNCHES = MK_N_LAUNCHES;

constexpr size_t MiB = 1u << 20;
constexpr size_t WS_CTL = 0, CTL_ZERO_BYTES = 64 * 1024;
constexpr size_t WS_WOC = 1 * MiB, WS_WOR = 3 * MiB, WS_WO = 5 * MiB;
constexpr size_t WS_STATS = 7 * MiB;
constexpr size_t WS_SGS = 9 * MiB;
constexpr size_t WS_H = 11 * MiB;
constexpr size_t WS_U = 45 * MiB, WS_GC = 78 * MiB;
constexpr size_t WS_R = 111 * MiB, WS_K = 145 * MiB, WS_V = 179 * MiB, WS_ZR = 213 * MiB;
constexpr size_t WS_WA = 247 * MiB;
constexpr size_t WS_END = 256 * MiB;
constexpr size_t RKVZ_STRIDE = (WS_K - WS_R) / 2;
static_assert(WS_V - WS_K == WS_K - WS_R && WS_ZR - WS_V == WS_K - WS_R, "R|K|V|ZR equally spaced");
static_assert(WS_H + (size_t)NROWP * D * 2 <= WS_U && WS_U + (size_t)NROW * D * 2 <= WS_GC && WS_GC + (size_t)NROW * D * 2 <= WS_R && WS_U + (size_t)NROW * D * 4 <= WS_R, "ws map 1");
static_assert(WS_R + (size_t)NROWP * D * 2 <= WS_K && WS_ZR + (size_t)NROWP * D * 2 <= WS_WA && WS_WA + (size_t)NROWP * 256 * 2 <= WS_END, "ws map 2");
constexpr size_t O_Y = 0, O_NCP = 17301504, O_NSP = 17317888, O_NRP = 17326080, O_NCS = 17850368, O_NSS = 18112512, O_NRS = 18243584, O_END = 26632192;
static_assert((size_t)NT_IN * 256 * D * 2 <= (O_END - O_NRS) * 4, "Wt_in fits in the new_rwkv_sample region");
constexpr int CW_BAR = 4096;

constexpr int RING_OFF = 0, RING_BYTES = 131072;
constexpr int LDSCTL_OFF = 162816, MISC_OFF = LDSCTL_OFF + 320;
constexpr int LDS_BYTES = 163840;

typedef unsigned u32x2 __attribute__((ext_vector_type(2)));
__device__ __forceinline__ float bf2f(unsigned short h) { return __uint_as_float((unsigned)h << 16); }
__device__ __forceinline__ float bflo(unsigned w) { return __uint_as_float(w << 16); }
__device__ __forceinline__ float bfhi(unsigned w) { return __uint_as_float(w & 0xffff0000u); }
__device__ __forceinline__ float sigmoidf_(float x) { return __builtin_amdgcn_rcpf(1.0f + __expf(-x)); }
__device__ __forceinline__ float wave_sum(float v) {
#pragma unroll
    for (int o = 1; o < 64; o <<= 1) v += __shfl_xor(v, o);
    return v;
}
__host__ __device__ __forceinline__ int col2slot(int c) { return (c & ~31) | (((c >> 2) & 1) << 4) | (((c >> 3) & 3) << 2) | (c & 3); }
__device__ __forceinline__ int win_dst_row(int n) {
    if (n < 4096) { const int g = n >> 10, ch = n & 1023, pn = ch >> 6, cl = ch & 63;
        return pn * 256 + ((g >> 1) << 7) + ((cl >> 4) << 5) + ((g & 1) << 4) + (cl & 15); }
    if (n < 7168) { const int cc = n - 4096; return (16 + (cc >> 8)) * 256 + col2slot(cc & 255); }
    if (n < 7296) return 32 * 256 + col2slot(n - 7168);
    if (n < 8320) { const int cc = n - 7296; return (28 + (cc >> 8)) * 256 + col2slot(cc & 255); }
    { const int cc = n - 8320; return (33 + (cc >> 8)) * 256 + col2slot(cc & 255); }
}

struct P1Order {
    int G, c;
    __device__ __forceinline__ bool next(int i, pg8::Unit& u) const {
        constexpr int nM = 66, nN = NT_IN, nwg = nM * nN;
        const int L = i * G + c; if (L >= nwg + 17) return false;
        if (L >= nwg) { u.pm = 66; u.pn = 16 + (L - nwg); return true; }
        int wgid = L; { const int q = nwg / 8, r = nwg % 8, xcd = wgid % 8, off = wgid / 8; wgid = (xcd < r ? xcd * (q + 1) : r * (q + 1) + (xcd - r) * q) + off; }
        const int nig = 8 * nN, gid = wgid / nig, fm = gid * 8, gsz = (nM - fm) < 8 ? (nM - fm) : 8;
        u.pm = fm + ((wgid % nig) % gsz); u.pn = (wgid % nig) / gsz; return true;
    }
    __device__ __forceinline__ void a_ready(const pg8::Unit&) const {}
    __device__ __forceinline__ void done(const pg8::Unit&) const {}
};

typedef v4u u32x4; typedef bf16 bf16_t;
__device__ __forceinline__ unsigned cvt_pk_bf16(float lo, float hi) { unsigned r; asm volatile("v_cvt_pk_bf16_f32 %0, %1, %2" : "=v"(r) : "v"(lo), "v"(hi)); return r; }
__device__ __forceinline__ u32x4 pack8(const f32x4 v0, const f32x4 v1) { u32x4 w; w.x = cvt_pk_bf16(v0[0], v0[1]); w.y = cvt_pk_bf16(v0[2], v0[3]); w.z = cvt_pk_bf16(v1[0], v1[1]); w.w = cvt_pk_bf16(v1[2], v1[3]); return w; }

struct EpiP1 {
    static constexpr bool PERM = false, AFTER_DRAIN = false;
    bf16_t *U, *GC, *R, *WA, *SGCp, *SGCs; float *ncp, *ncs;
    __device__ __forceinline__ void operator()(const f32x4 (&acc)[2][2][4][2], const pg8::Unit& u, int wr, int wc, int fr, int fq) const {
        const int row0 = u.pm * 256 + wr * 64 + fr;
        if (u.pn < 16) {
            const int ch = u.pn * 64 + wc * 16 + fq * 4;
#pragma unroll
            for (int ai = 0; ai < 2; ++ai)
#pragma unroll
                for (int m = 0; m < 4; ++m) {
                    const int row = row0 + ai * 128 + m * 16;
                    const f32x4 xin = acc[ai][0][m][0], bg = acc[ai][0][m][1], cg = acc[ai][1][m][0], zc = acc[ai][1][m][1];
                    f32x4 uu, gg;
#pragma unroll
                    for (int j = 0; j < 4; ++j) { uu[j] = cg[j] * xin[j]; gg[j] = bg[j] * zc[j] * sigmoidf_(zc[j]); }
                    u32x2 wu, wg; wu.x = cvt_pk_bf16(uu[0], uu[1]); wu.y = cvt_pk_bf16(uu[2], uu[3]); wg.x = cvt_pk_bf16(gg[0], gg[1]); wg.y = cvt_pk_bf16(gg[2], gg[3]);
                    *(u32x2*)(U + (size_t)row * D + ch) = wu; *(u32x2*)(GC + (size_t)row * D + ch) = wg;
                    if (row < NPR) { const int t = row & (SEQ - 1); if (t >= SEQ - 2) *(f32x4*)(ncp + ((size_t)(row >> 11) * 2 + (t - (SEQ - 2))) * D + ch) = uu; }
                    else { const int rs = row - NPR, t = rs & 3; if (t >= 2) *(f32x4*)(ncs + ((size_t)(rs >> 2) * 2 + (t - 2)) * D + ch) = uu; }
                }
            return;
        }
        bf16_t* base; int ldc = D, colt; bool sig = false;
        if (u.pn < 32) { const int g = (u.pn - 16) >> 2; base = R + (size_t)g * RKVZ_STRIDE; colt = ((u.pn - 16) & 3) * 256; }
        else if (u.pn == 32) { base = WA; ldc = 256; colt = 0; }
        else { sig = true; const int g = (u.pn - 33) >> 2; colt = ((u.pn - 33) & 3) * 256;
               if (u.pm < 64) base = SGCp + (size_t)g * NPR * D; else base = SGCs + (size_t)g * NSR * D - (size_t)NPR * D; }
        const int col0 = colt + wc * 32 + 8 * fq;
#pragma unroll
        for (int ai = 0; ai < 2; ++ai)
#pragma unroll
            for (int m = 0; m < 4; ++m) { bf16_t* rowp = base + (size_t)(row0 + ai * 128 + m * 16) * ldc + col0;
#pragma unroll
                for (int bj = 0; bj < 2; ++bj) { f32x4 v0 = acc[ai][bj][m][0], v1 = acc[ai][bj][m][1];
                    if (sig) {
#pragma unroll
                        for (int j = 0; j < 4; ++j) { v0[j] = sigmoidf_(v0[j]); v1[j] = sigmoidf_(v1[j]); } }
                    *(u32x4*)(rowp + bj * 128) = pack8(v0, v1); } }
    }
};
__device__ __forceinline__ void unpack8(const u32x4 w, f32x4& a, f32x4& b) { a[0] = bflo(w.x); a[1] = bfhi(w.x); a[2] = bflo(w.y); a[3] = bfhi(w.y); b[0] = bflo(w.z); b[1] = bfhi(w.z); b[2] = bflo(w.w); b[3] = bfhi(w.w); }
struct EpiT1 {
    static constexpr bool PERM = false, AFTER_DRAIN = false;
    float* T1; const bf16_t *SGp, *SGs;
    __device__ __forceinline__ void operator()(const f32x4 (&acc)[2][2][4][2], const pg8::Unit& u, int wr, int wc, int fr, int fq) const {
        const int row0 = u.pm * 256 + wr * 64 + fr, col0 = u.pn * 256 + wc * 32 + 8 * fq;
        const bf16_t* sg = u.pm < 64 ? SGp : SGs - (size_t)NPR * D;
#pragma unroll
        for (int ai = 0; ai < 2; ++ai)
#pragma unroll
            for (int m = 0; m < 4; ++m) { const size_t off = (size_t)(row0 + ai * 128 + m * 16) * D + col0;
#pragma unroll
                for (int bj = 0; bj < 2; ++bj) { f32x4 g0, g1; unpack8(*(const u32x4*)(sg + off + bj * 128), g0, g1);
                    *(f32x4*)(T1 + off + bj * 128) = acc[ai][bj][m][0] * g0; *(f32x4*)(T1 + off + bj * 128 + 4) = acc[ai][bj][m][1] * g1; } }
    }
};
struct EpiM {
    static constexpr bool PERM = false, AFTER_DRAIN = false;
    const float* T1; bf16_t* M; const bf16_t *SGp, *SGs;
    __device__ __forceinline__ void operator()(const f32x4 (&acc)[2][2][4][2], const pg8::Unit& u, int wr, int wc, int fr, int fq) const {
        const int row0 = u.pm * 256 + wr * 64 + fr, col0 = u.pn * 256 + wc * 32 + 8 * fq;
        const bf16_t* sg = u.pm < 64 ? SGp : SGs - (size_t)NPR * D;
#pragma unroll
        for (int ai = 0; ai < 2; ++ai)
#pragma unroll
            for (int m = 0; m < 4; ++m) { const size_t off = (size_t)(row0 + ai * 128 + m * 16) * D + col0;
#pragma unroll
                for (int bj = 0; bj < 2; ++bj) { f32x4 g0, g1; unpack8(*(const u32x4*)(sg + off + bj * 128), g0, g1);
                    const f32x4 t0 = *(const f32x4*)(T1 + off + bj * 128), t1 = *(const f32x4*)(T1 + off + bj * 128 + 4);
                    *(u32x4*)(M + off + bj * 128) = pack8(t0 + acc[ai][bj][m][0] * g0, t1 + acc[ai][bj][m][1] * g1); } }
    }
};
struct EpiXo {
    static constexpr bool PERM = false, AFTER_DRAIN = false;
    const float *xp, *xs; float* out; float* stats;
    __device__ __forceinline__ void operator()(const f32x4 (&acc)[2][2][4][2], const pg8::Unit& u, int wr, int wc, int fr, int fq) const {
        const int row0 = u.pm * 256 + wr * 64 + fr, col0 = u.pn * 256 + wc * 32 + 8 * fq;
        const float* x = u.pm < 64 ? xp : xs - (size_t)NPR * D;
#pragma unroll
        for (int ai = 0; ai < 2; ++ai)
#pragma unroll
            for (int m = 0; m < 4; ++m) { const int row = row0 + ai * 128 + m * 16; const size_t off = (size_t)row * D + col0; float ss = 0.f;
#pragma unroll
                for (int bj = 0; bj < 2; ++bj) {
                    const f32x4 o0 = *(const f32x4*)(x + off + bj * 128) + acc[ai][bj][m][0], o1 = *(const f32x4*)(x + off + bj * 128 + 4) + acc[ai][bj][m][1];
                    *(f32x4*)(out + off + bj * 128) = o0; *(f32x4*)(out + off + bj * 128 + 4) = o1;
                    ss += (o0[0] * o0[0] + o0[1] * o0[1]) + (o0[2] * o0[2] + o0[3] * o0[3]) + (o1[0] * o1[0] + o1[1] * o1[1]) + (o1[2] * o1[2] + o1[3] * o1[3]); }
                ss += __shfl_xor(ss, 16); ss += __shfl_xor(ss, 32);
                if (fq == 0) stats[(size_t)row * 16 + u.pn * 4 + wc] = ss; }
    }
};

struct Frame {
    LAS unsigned char* lds;
    volatile LAS unsigned* MISC;
    gu32* ctl;
    int tid, lane, wave, G;
    const float *x_prompt, *x_sample, *state_conv, *state_shift, *state_rwkv, *norm_g, *w_in, *conv_w, *mu, *w0, *w_up, *a0, *a_up, *k_k, *k_a, *r_k, *ln_w, *ln_b, *w_out_c, *w_out_r, *w_o, *final_g;
    float* out;
    bf16 *Wt_in, *Wt_oc, *Wt_or, *Wt_o, *H, *U, *GC, *R, *K, *V, *ZR, *WA, *SGCp, *SGRp, *SGCs, *SGRs;
    float *T1, *STATS;
};

template <class DST>
__device__ __forceinline__ void p0_transpose_item(const float* W, int K, int N, bf16* WT, LAS float* scr, int item, int lane, DST dst) {
    const int nblk = N / 32, kb = item / nblk, nb = item % nblk, k0 = 64 * kb, n0 = 32 * nb;
#pragma unroll 8
    for (int i = 0; i < 32; ++i) { const int kk = 2 * i + (lane >> 5); scr[kk * 33 + (lane & 31)] = W[(size_t)(k0 + kk) * N + n0 + (lane & 31)]; }
    LDS_WAIT(); asm volatile("" ::: "memory");
    const int c = lane & 7;
#pragma unroll
    for (int j = 0; j < 4; ++j) { const int n = (lane >> 3) + 8 * j; const LAS float* s = scr + (8 * c) * 33 + n;
        v4u o; o.x = pk2(s[0 * 33], s[1 * 33]); o.y = pk2(s[2 * 33], s[3 * 33]); o.z = pk2(s[4 * 33], s[5 * 33]); o.w = pk2(s[6 * 33], s[7 * 33]);
        *(GAS v4u*)(WT + (size_t)dst(n0 + n) * K + k0 + 8 * c) = o; }
    LDS_WAIT(); asm volatile("" ::: "memory");
}
struct DstIn { __device__ __forceinline__ int operator()(int n) const { return win_dst_row(n); } };
struct DstSlot { __device__ __forceinline__ int operator()(int n) const { return col2slot(n); } };

__device__ __forceinline__ void rms_row(Frame& F, const float* xrow, const float* g, bf16* orow, float* f32row) {
    const GAS f32x4* xr = (const GAS f32x4*)xrow + F.lane; const GAS f32x4* gr = (const GAS f32x4*)g + F.lane;
    f32x4 v[4]; float s = 0.f;
#pragma unroll
    for (int j = 0; j < 4; ++j) { v[j] = xr[64 * j]; s += (v[j].x * v[j].x + v[j].y * v[j].y) + (v[j].z * v[j].z + v[j].w * v[j].w); }
    const float rs = 1.0f / sqrtf(wave_sum(s) * (1.f / D) + RMS_EPS);
    GAS unsigned long long* o8 = (GAS unsigned long long*)orow + F.lane;
#pragma unroll
    for (int j = 0; j < 4; ++j) { const f32x4 y = (v[j] * rs) * gr[64 * j];
        o8[64 * j] = (unsigned long long)pk2(y.x, y.y) | ((unsigned long long)pk2(y.z, y.w) << 32);
        if (f32row) ((GAS f32x4*)f32row)[64 * j + F.lane] = y; }
}
__device__ __forceinline__ void p0_prologue(Frame& F) {
    LAS float* scr = (LAS float*)(F.lds + RING_OFF + F.wave * 16384);
    const int gw = blockIdx.x * NWAVES + F.wave, NGW = F.G * NWAVES;
    constexpr int I_IN = (D / 64) * (N_IN / 32), I_SQ = (D / 64) * (D / 32);
    constexpr int NITEMS = I_IN + 3 * I_SQ;
    for (int it = gw; it < NITEMS; it += NGW) {
        int r = it;
        if (r < I_IN) { p0_transpose_item(F.w_in, D, N_IN, F.Wt_in, scr, r, F.lane, DstIn()); continue; } r -= I_IN;
        if (r < I_SQ) { p0_transpose_item(F.w_out_c, D, D, F.Wt_oc, scr, r, F.lane, DstSlot()); continue; } r -= I_SQ;
        if (r < I_SQ) { p0_transpose_item(F.w_out_r, D, D, F.Wt_or, scr, r, F.lane, DstSlot()); continue; } r -= I_SQ;
        p0_transpose_item(F.w_o, D, D, F.Wt_o, scr, r, F.lane, DstSlot());
    }
    for (int m = gw; m < 256; m += NGW) { bf16* p = m < 128 ? F.Wt_in + (size_t)(32 * 256 + 128 + m) * D : F.H + (size_t)(NROW + 128 + (m - 128)) * D;
        GAS v4u* o = (GAS v4u*)p + F.lane; o[0] = (v4u){0u, 0u, 0u, 0u}; o[64] = (v4u){0u, 0u, 0u, 0u}; }
    for (int m = gw; m < NROW + DBATCH; m += NGW) {
        if (m < NPR) { const int t = m & (SEQ - 1); rms_row(F, F.x_prompt + (size_t)m * D, F.norm_g, F.H + (size_t)m * D, t == SEQ - 1 ? F.out + O_NSP + (size_t)(m >> 11) * D : nullptr); }
        else if (m < NROW) { const int rs = m - NPR; rms_row(F, F.x_sample + (size_t)rs * D, F.norm_g, F.H + (size_t)m * D, (rs & 3) == 3 ? F.out + O_NSS + (size_t)(rs >> 2) * D : nullptr); }
        else { const GAS f32x4* xr = (const GAS f32x4*)(F.state_shift + (size_t)(m - NROW) * D) + F.lane; GAS unsigned long long* o8 = (GAS unsigned long long*)(F.H + (size_t)m * D) + F.lane;
#pragma unroll
            for (int j = 0; j < 4; ++j) { const f32x4 y = xr[64 * j]; o8[64 * j] = (unsigned long long)pk2(y.x, y.y) | ((unsigned long long)pk2(y.z, y.w) << 32); } }
    }
}

__device__ __forceinline__ void p2_convmix(Frame& F, int part, int nparts) {
    bf16* YC = F.H;
    const int gt = part * (NWAVES * 64) + F.tid, NT = nparts * NWAVES * 64;
    for (int it = gt; it < NROW * 128; it += NT) {
        const int row = it >> 7, ch = (it & 127) * 8;
        int tis, b = 0; if (row < NPR) tis = row & (SEQ - 1); else { const int rs = row - NPR; tis = rs & 3; b = rs >> 2; }
        const bool smp = row >= NPR;
        f32x4 u0a, u0b, u1a, u1b, u2a, u2b, ga, gb;
        unpack8(*(const GAS v4u*)(F.U + (size_t)row * D + ch), u0a, u0b);
        unpack8(*(const GAS v4u*)(F.GC + (size_t)row * D + ch), ga, gb);
        if (tis >= 1) unpack8(*(const GAS v4u*)(F.U + (size_t)(row - 1) * D + ch), u1a, u1b);
        else if (smp) { const float* s = F.state_conv + ((size_t)b * 2 + 1) * D + ch; u1a = *(const GAS f32x4*)s; u1b = *(const GAS f32x4*)(s + 4); }
        else { u1a = (f32x4){0.f, 0.f, 0.f, 0.f}; u1b = u1a; }
        if (tis >= 2) unpack8(*(const GAS v4u*)(F.U + (size_t)(row - 2) * D + ch), u2a, u2b);
        else if (smp) { const float* s = F.state_conv + ((size_t)b * 2 + tis) * D + ch; u2a = *(const GAS f32x4*)s; u2b = *(const GAS f32x4*)(s + 4); }
        else { u2a = (f32x4){0.f, 0.f, 0.f, 0.f}; u2b = u2a; }
        const f32x4 c0a = *(const GAS f32x4*)(F.conv_w + ch), c0b = *(const GAS f32x4*)(F.conv_w + ch + 4);
        const f32x4 c1a = *(const GAS f32x4*)(F.conv_w + D + ch), c1b = *(const GAS f32x4*)(F.conv_w + D + ch + 4);
        const f32x4 c2a = *(const GAS f32x4*)(F.conv_w + 2 * D + ch), c2b = *(const GAS f32x4*)(F.conv_w + 2 * D + ch + 4);
        const f32x4 ya = ga * (c0a * u2a + c1a * u1a + c2a * u0a), yb = gb * (c0b * u2b + c1b * u1b + c2b * u0b);
        *(GAS v4u*)(YC + (size_t)row * D + ch) = pack8(ya, yb);
    }
}

typedef _Float16 h8 __attribute__((ext_vector_type(8)));
typedef _Float16 h4 __attribute__((ext_vector_type(4)));
#define MFMA16(a, b, c) __builtin_amdgcn_mfma_f32_16x16x32_f16((a), (b), (c), 0, 0, 0)
#define LH(p) ((LAS _Float16*)(p))
constexpr int SCAN_WUPT = 0, SCAN_AUPT = 8192, SCAN_CONST = 16384, SCAN_PREV = 19968  , SCAN_SLOT0 = 24576;
constexpr int S_KT = 0, S_RT = 2048, S_BK = 4096, S_VT = 8192, S_ABR = 10240, S_AKK = 11264, S_MINV = 11776, S_RHO = 12288, S_C1 = 12544, S_Y = 12800, SLOT_BYTES = 16896;
constexpr int S_TW = S_KT, S_XA = S_RT, S_BT = S_Y, S_KHT = S_Y + 2048;
static_assert(SCAN_SLOT0 + 8 * SLOT_BYTES <= LDSCTL_OFF, "scan LDS");
#define DPP_F(v, ctrl) __builtin_bit_cast(float, __builtin_amdgcn_update_dpp(0, __builtin_bit_cast(int, (v)), (ctrl), 0xF, 0xF, true))
__device__ __forceinline__ float red16(float v) {
    v += DPP_F(v, 0xB1); v += DPP_F(v, 0x4E); v += DPP_F(v, 0x141); v += DPP_F(v, 0x140); return v;
}
__device__ __forceinline__ h4 cvt4(const f32x4 x) { return __builtin_convertvector(x, h4); }
__device__ __forceinline__ h8 cat44(const h4 a, const h4 b) { return (h8){a[0], a[1], a[2], a[3], b[0], b[1], b[2], b[3]}; }
__device__ __forceinline__ h8 frag4h(const h4 a) { const _Float16 z = (_Float16)0.f; return (h8){a[0], a[1], a[2], a[3], z, z, z, z}; }
__device__ __forceinline__ h8 frag4(const f32x4 x) { return frag4h(cvt4(x)); }
__device__ __forceinline__ float fast_tanh(float x) { return 1.0f - 2.0f * __builtin_amdgcn_rcpf(1.0f + __expf(2.0f * x)); }

__device__ __forceinline__ void scan_load_head(Frame& F, LAS unsigned char* SC, int h) {
    for (int i = F.tid; i < 4096; i += NWAVES * 64) { const int c = i >> 6, r = i & 63;
        LH(SC + SCAN_WUPT)[i] = (_Float16)F.w_up[r * D + h * 64 + c]; LH(SC + SCAN_AUPT)[i] = (_Float16)F.a_up[r * D + h * 64 + c]; }
    LAS float* CN = (LAS float*)(SC + SCAN_CONST);
    for (int i = F.tid; i < 13 * 64; i += NWAVES * 64) { const int a = i >> 6, c = i & 63, col = h * 64 + c; float v;
        switch (a) { case 0: v = F.mu[col]; break; case 1: v = F.mu[1024 + col]; break; case 2: v = F.mu[2048 + col]; break; case 3: v = F.mu[3200 + col]; break;
                     case 4: v = F.mu[3072 + c]; break; case 5: v = F.mu[3136 + c]; break; case 6: v = F.w0[col]; break; case 7: v = F.a0[col]; break;
                     case 8: v = F.k_k[col]; break; case 9: v = F.k_a[col]; break; case 10: v = F.r_k[col]; break; case 11: v = F.ln_w[col]; break; default: v = F.ln_b[col]; break; }
        CN[i] = v; }
}

__device__ __forceinline__ void unpack4(const u32x2 w, float (&o)[4]) { o[0] = bflo(w.x); o[1] = bfhi(w.x); o[2] = bflo(w.y); o[3] = bfhi(w.y); }
__device__ __forceinline__ void produce_chunk(Frame& F, LAS unsigned char* SC, LAS unsigned char* slot, int h, int g0, int T0, int nvalid, int plast_row,
                                              const LAS float* prev_in, LAS float* prev_out, float (&vv)[4][4], float (&zg)[4][4], float (&bon)[4]) {
    const int lane = F.lane, c16 = lane & 15, q = lane >> 4, c4 = 4 * c16;
    const LAS float* CN = (const LAS float*)(SC + SCAN_CONST);
    const int trow0 = T0 + 4 * q;
    const size_t row0 = (size_t)(g0 + trow0);
    const bool first = trow0 == 0, has_prev = !first || plast_row >= 0;
    const size_t prow = first ? (size_t)(plast_row >= 0 ? plast_row : 0) : row0 - 1;
    const bool valid = 4 * q < nvalid;
    float xr[4][4], xk[4][4];
    float n2[4] = {0.f, 0.f, 0.f, 0.f}, bs[4] = {0.f, 0.f, 0.f, 0.f};
    {
        float pr[4], pk[4], pv[4], pz[4], pw[4], pa[4];
        if (q == 0 && prev_in) {
#pragma unroll
            for (int ct = 0; ct < 4; ++ct) { pr[ct] = prev_in[c4 + ct]; pk[ct] = prev_in[64 + c4 + ct]; pv[ct] = prev_in[128 + c4 + ct]; pz[ct] = prev_in[192 + c4 + ct]; pw[ct] = prev_in[256 + c4 + ct]; pa[ct] = prev_in[320 + c4 + ct]; }
        } else if (has_prev) { const size_t o = prow * D + h * 64 + c4;
            unpack4(*(const GAS u32x2*)(F.R + o), pr); unpack4(*(const GAS u32x2*)(F.K + o), pk); unpack4(*(const GAS u32x2*)(F.V + o), pv); unpack4(*(const GAS u32x2*)(F.ZR + o), pz);
            unpack4(*(const GAS u32x2*)(F.WA + prow * 256 + c4), pw); unpack4(*(const GAS u32x2*)(F.WA + prow * 256 + 64 + c4), pa);
        } else {
#pragma unroll
            for (int ct = 0; ct < 4; ++ct) { pr[ct] = 0.f; pk[ct] = 0.f; pv[ct] = 0.f; pz[ct] = 0.f; pw[ct] = 0.f; pa[ct] = 0.f; }
        }
        const f32x4 mr = *(const LAS f32x4*)(CN + c4), mk = *(const LAS f32x4*)(CN + 64 + c4), mv = *(const LAS f32x4*)(CN + 128 + c4), mz = *(const LAS f32x4*)(CN + 192 + c4),
                    mw = *(const LAS f32x4*)(CN + 256 + c4), ma = *(const LAS f32x4*)(CN + 320 + c4), kkc = *(const LAS f32x4*)(CN + 8 * 64 + c4);
#pragma unroll
        for (int reg = 0; reg < 4; ++reg) {
            const size_t ro = (row0 + reg) * D + h * 64 + c4, wo = (row0 + reg) * 256 + c4;
            float r[4], k[4], v[4], z[4], wd[4], ad[4];
            unpack4(*(const GAS u32x2*)(F.R + ro), r); unpack4(*(const GAS u32x2*)(F.K + ro), k); unpack4(*(const GAS u32x2*)(F.V + ro), v); unpack4(*(const GAS u32x2*)(F.ZR + ro), z);
            unpack4(*(const GAS u32x2*)(F.WA + wo), wd); unpack4(*(const GAS u32x2*)(F.WA + wo + 64), ad);
            f32x4 tw, xa;
#pragma unroll
            for (int ct = 0; ct < 4; ++ct) {
                xr[ct][reg] = r[ct] + (pr[ct] - r[ct]) * mr[ct]; const float xk_ = k[ct] + (pk[ct] - k[ct]) * mk[ct]; xk[ct][reg] = xk_; n2[reg] += (xk_ * kkc[ct]) * (xk_ * kkc[ct]);
                vv[ct][reg] = v[ct] + (pv[ct] - v[ct]) * mv[ct]; const float xz = z[ct] + (pz[ct] - z[ct]) * mz[ct]; zg[ct][reg] = xz * sigmoidf_(xz);
                tw[ct] = fast_tanh(wd[ct] + (pw[ct] - wd[ct]) * mw[ct]); xa[ct] = ad[ct] + (pa[ct] - ad[ct]) * ma[ct];
                pr[ct] = r[ct]; pk[ct] = k[ct]; pv[ct] = v[ct]; pz[ct] = z[ct]; pw[ct] = wd[ct]; pa[ct] = ad[ct];
            }
            *(LAS h4*)(LH(slot + S_TW) + (4 * q + reg) * 64 + c4) = cvt4(tw); *(LAS h4*)(LH(slot + S_XA) + (4 * q + reg) * 64 + c4) = cvt4(xa);
        }
        if (prev_out && q == 3) {
#pragma unroll
            for (int ct = 0; ct < 4; ++ct) { prev_out[c4 + ct] = pr[ct]; prev_out[64 + c4 + ct] = pk[ct]; prev_out[128 + c4 + ct] = pv[ct]; prev_out[192 + c4 + ct] = pz[ct]; prev_out[256 + c4 + ct] = pw[ct]; prev_out[320 + c4 + ct] = pa[ct]; }
        }
    }
    float lg[4][4], av[4][4];
    {
        const h8 ta0 = *(const LAS h8*)(LH(slot + S_TW) + c16 * 64 + q * 8), ta1 = *(const LAS h8*)(LH(slot + S_TW) + c16 * 64 + 32 + q * 8);
        const h8 xa0 = *(const LAS h8*)(LH(slot + S_XA) + c16 * 64 + q * 8), xa1 = *(const LAS h8*)(LH(slot + S_XA) + c16 * 64 + 32 + q * 8);
        const f32x4 w0c = *(const LAS f32x4*)(CN + 6 * 64 + c4), a0c = *(const LAS f32x4*)(CN + 7 * 64 + c4), kac = *(const LAS f32x4*)(CN + 9 * 64 + c4), rkc = *(const LAS f32x4*)(CN + 10 * 64 + c4);
#pragma unroll
        for (int ct = 0; ct < 4; ++ct) {
            const LAS _Float16* wu = LH(SC + SCAN_WUPT) + (c4 + ct) * 64 + q * 8; const LAS _Float16* au = LH(SC + SCAN_AUPT) + (c4 + ct) * 64 + q * 8;
            f32x4 wl = (f32x4){0.f, 0.f, 0.f, 0.f}, al = wl;
            wl = MFMA16(ta0, *(const LAS h8*)wu, wl); wl = MFMA16(ta1, *(const LAS h8*)(wu + 32), wl);
            al = MFMA16(xa0, *(const LAS h8*)au, al); al = MFMA16(xa1, *(const LAS h8*)(au + 32), al);
#pragma unroll
            for (int reg = 0; reg < 4; ++reg) {
                lg[ct][reg] = valid ? -0.6065306597126334f * sigmoidf_(w0c[ct] + wl[reg]) : 0.f;
                const float a = sigmoidf_(a0c[ct] + al[reg]); av[ct][reg] = a;
                bs[reg] += xr[ct][reg] * (xk[ct][reg] * (1.0f + (a - 1.0f) * kac[ct])) * rkc[ct];
            }
        }
    }
    float inv[4];
#pragma unroll
    for (int reg = 0; reg < 4; ++reg) { inv[reg] = valid ? 1.0f / fmaxf(sqrtf(red16(n2[reg])), 1e-12f) : 0.f; bon[reg] = red16(bs[reg]); }
    if (!valid) {
#pragma unroll
        for (int ct = 0; ct < 4; ++ct)
#pragma unroll
            for (int reg = 0; reg < 4; ++reg) { xk[ct][reg] = 0.f; vv[ct][reg] = 0.f; xr[ct][reg] = 0.f; }
    }
    {
    const f32x4 kkc = *(const LAS f32x4*)(CN + 8 * 64 + c4), kac = *(const LAS f32x4*)(CN + 9 * 64 + c4);
#pragma unroll
    for (int ct = 0; ct < 4; ++ct) {
        float Lin[4]; Lin[0] = lg[ct][0]; Lin[1] = Lin[0] + lg[ct][1]; Lin[2] = Lin[1] + lg[ct][2]; Lin[3] = Lin[2] + lg[ct][3];
        const float tot = Lin[3], t1 = __shfl(tot, lane - 16), t2 = __shfl(tot, lane - 32), t3 = __shfl(tot, lane - 48);
        const float off = (q >= 1 ? t1 : 0.f) + (q >= 2 ? t2 : 0.f) + (q >= 3 ? t3 : 0.f);
#pragma unroll
        for (int reg = 0; reg < 4; ++reg) Lin[reg] += off;
        const float Lref = __shfl(Lin[3], c16 + 16), L15 = __shfl(Lin[3], c16 + 48);
        const int pos = 32 * (ct >> 1) + 8 * (c16 >> 2) + 4 * (ct & 1) + (c16 & 3);
        f32x4 btv, khv;
#pragma unroll
        for (int reg = 0; reg < 4; ++reg) {
            const float e1 = __expf(Lin[reg] - lg[ct][reg] - Lref), e2 = __expf(Lin[reg] - Lref), e3 = __expf(Lref - Lin[reg]);
            const float a = av[ct][reg], k = xk[ct][reg], kk = k * kkc[ct] * inv[reg], kh = k * (1.0f + (a - 1.0f) * kac[ct]);
            const float kt = kk * e1, rt = xr[ct][reg] * e2, bt = kk * a * e3, kht = kh * e3;
            const int o = (4 * q + reg) * 64 + pos;
            LH(slot + S_KT)[o] = (_Float16)kt; LH(slot + S_RT)[o] = (_Float16)rt; LH(slot + S_BT)[o] = (_Float16)bt; LH(slot + S_KHT)[o] = (_Float16)kht;
            btv[reg] = -bt; khv[reg] = kht;
        }
        *(LAS h8*)(LH(slot + S_BK) + ct * 512 + c16 * 32 + q * 8) = cat44(cvt4(btv), cvt4(khv));
        { f32x4 v4; v4[0] = vv[ct][0]; v4[1] = vv[ct][1]; v4[2] = vv[ct][2]; v4[3] = vv[ct][3]; *(LAS h4*)(LH(slot + S_VT) + (16 * ct + c16) * 16 + 4 * q) = cvt4(v4); }
        if (q == 0) { const int o = (c16 >> 2) * 16 + ct * 4 + (c16 & 3); ((LAS float*)(slot + S_RHO))[o] = __expf(Lref); ((LAS float*)(slot + S_C1))[o] = __expf(L15 - Lref); }
    }
    }
    const h8 kt0 = *(const LAS h8*)(LH(slot + S_KT) + c16 * 64 + q * 8), kt1 = *(const LAS h8*)(LH(slot + S_KT) + c16 * 64 + 32 + q * 8);
    const h8 rt0 = *(const LAS h8*)(LH(slot + S_RT) + c16 * 64 + q * 8), rt1 = *(const LAS h8*)(LH(slot + S_RT) + c16 * 64 + 32 + q * 8);
    const h8 bt0 = *(const LAS h8*)(LH(slot + S_BT) + c16 * 64 + q * 8), bt1 = *(const LAS h8*)(LH(slot + S_BT) + c16 * 64 + 32 + q * 8);
    const h8 kh0 = *(const LAS h8*)(LH(slot + S_KHT) + c16 * 64 + q * 8), kh1 = *(const LAS h8*)(LH(slot + S_KHT) + c16 * 64 + 32 + q * 8);
    const f32x4 z4 = (f32x4){0.f, 0.f, 0.f, 0.f};
    f32x4 Akk = MFMA16(kh0, kt0, z4); Akk = MFMA16(kh1, kt1, Akk);
    f32x4 Abr = MFMA16(bt0, rt0, z4); Abr = MFMA16(bt1, rt1, Abr);
    f32x4 Akr = MFMA16(kh0, rt0, z4); Akr = MFMA16(kh1, rt1, Akr);
    f32x4 N = MFMA16(bt0, kt0, z4); N = MFMA16(bt1, kt1, N);
    f32x4 NT = MFMA16(kt0, bt0, z4); NT = MFMA16(kt1, bt1, NT);
    f32x4 I4;
#pragma unroll
    for (int reg = 0; reg < 4; ++reg) { const int rw = 4 * q + reg;
        Akk[reg] = rw < c16 ? Akk[reg] : 0.f; Abr[reg] = rw <= c16 ? -Abr[reg] : 0.f; Akr[reg] = rw <= c16 ? Akr[reg] : 0.f;
        N[reg] = rw < c16 ? N[reg] : 0.f; NT[reg] = c16 < rw ? NT[reg] : 0.f; I4[reg] = rw == c16 ? 1.f : 0.f; }
    *(LAS h4*)(LH(slot + S_AKK) + c16 * 16 + 4 * q) = cvt4(Akk);
    *(LAS h8*)(LH(slot + S_ABR) + c16 * 32 + q * 8) = cat44(cvt4(Abr), cvt4(Akr));
    const h8 fN = frag4(N), fNT = frag4(NT);
    const f32x4 T1 = I4 - N, T1T = I4 - NT;
    const h8 fT1T = frag4(T1T);
    const f32x4 N2 = MFMA16(fNT, fN, z4), N2T = MFMA16(fN, fNT, z4);
    const h8 fN2 = frag4(N2), fN2T = frag4(N2T);
    const f32x4 T2 = MFMA16(fT1T, fN2, T1), T2T = MFMA16(fN2, fT1T, T1T);
    const f32x4 N4 = MFMA16(fN2T, fN2, z4), N4T = MFMA16(fN2, fN2T, z4);
    const h8 fN4 = frag4(N4), fN4T = frag4(N4T), fT2T = frag4(T2T);
    const f32x4 T3 = MFMA16(fT2T, fN4, T2), T3T = MFMA16(fN4, fT2T, T2T);
    const f32x4 N8 = MFMA16(fN4T, fN4, z4);
    const f32x4 Minv = MFMA16(frag4(T3T), frag4(N8), T3);
    *(LAS h4*)(LH(slot + S_MINV) + c16 * 16 + 4 * q) = cvt4(Minv);
}

__device__ __forceinline__ void consume_chunk(LAS unsigned char* slot, int vb, f32x4 (&zt)[4], int lane) {
    const int vl = lane & 15, q = lane >> 4;
    const LAS float* RHOq = (const LAS float*)(slot + S_RHO) + q * 16; const LAS float* C1q = (const LAS float*)(slot + S_C1) + q * 16;
    f32x4 zr[4];
#pragma unroll
    for (int kb = 0; kb < 4; ++kb) zr[kb] = zt[kb] * *(const LAS f32x4*)(RHOq + 4 * kb);
    const h8 zq0 = cat44(cvt4(zr[0]), cvt4(zr[1])), zq1 = cat44(cvt4(zr[2]), cvt4(zr[3]));
    const h4 vt4 = *(const LAS h4*)(LH(slot + S_VT) + (vb + vl) * 16 + 4 * q);
    const h8 kt0 = *(const LAS h8*)(LH(slot + S_KT) + vl * 64 + q * 8), kt1 = *(const LAS h8*)(LH(slot + S_KT) + vl * 64 + 32 + q * 8);
    const h8 rt0 = *(const LAS h8*)(LH(slot + S_RT) + vl * 64 + q * 8), rt1 = *(const LAS h8*)(LH(slot + S_RT) + vl * 64 + 32 + q * 8);
    const f32x4 z4 = (f32x4){0.f, 0.f, 0.f, 0.f};
    f32x4 X = MFMA16(kt0, zq0, z4); X = MFMA16(kt1, zq1, X);
    X = MFMA16(frag4h(*(const LAS h4*)(LH(slot + S_AKK) + vl * 16 + 4 * q)), frag4h(vt4), X);
    const f32x4 UT = MFMA16(frag4h(*(const LAS h4*)(LH(slot + S_MINV) + vl * 16 + 4 * q)), frag4(X), z4);
    const h8 uv = cat44(cvt4(UT), vt4);
    f32x4 Y = MFMA16(rt0, zq0, z4); Y = MFMA16(rt1, zq1, Y);
    Y = MFMA16(*(const LAS h8*)(LH(slot + S_ABR) + vl * 32 + q * 8), uv, Y);
#pragma unroll
    for (int kb = 0; kb < 4; ++kb) { const f32x4 zn = MFMA16(*(const LAS h8*)(LH(slot + S_BK) + kb * 512 + vl * 32 + q * 8), uv, zr[kb]); zt[kb] = zn * *(const LAS f32x4*)(C1q + 4 * kb); }
    LAS float* YB = (LAS float*)(slot + S_Y);
#pragma unroll
    for (int reg = 0; reg < 4; ++reg) YB[(4 * q + reg) * 64 + vb + vl] = Y[reg];
}

__device__ __forceinline__ void post_chunk(Frame& F, LAS unsigned char* SC, LAS unsigned char* slot, int h, size_t row0, int nvalid,
                                           const float (&vv)[4][4], const float (&zg)[4][4], const float (&bon)[4], bf16* YR) {
    const int lane = F.lane, c16 = lane & 15, q = lane >> 4;
    const LAS float* CN = (const LAS float*)(SC + SCAN_CONST); const LAS float* YB = (const LAS float*)(slot + S_Y);
    const bool valid = 4 * q < nvalid;
    float y[4][4];
#pragma unroll
    for (int ct = 0; ct < 4; ++ct)
#pragma unroll
        for (int reg = 0; reg < 4; ++reg) y[ct][reg] = YB[(4 * q + reg) * 64 + 16 * ct + c16];
#pragma unroll
    for (int reg = 0; reg < 4; ++reg) {
        const float mean = red16((y[0][reg] + y[1][reg]) + (y[2][reg] + y[3][reg])) * (1.f / 64.f);
        float d0 = y[0][reg] - mean, d1 = y[1][reg] - mean, d2 = y[2][reg] - mean, d3 = y[3][reg] - mean;
        const float var = red16((d0 * d0 + d1 * d1) + (d2 * d2 + d3 * d3)) * (1.f / 64.f), rstd = 1.0f / sqrtf(var + GN_EPS);
        y[0][reg] = d0 * rstd; y[1][reg] = d1 * rstd; y[2][reg] = d2 * rstd; y[3][reg] = d3 * rstd;
    }
    if (valid) {
        const f32x4 lw = *(const LAS f32x4*)(CN + 11 * 64 + 4 * c16), lb = *(const LAS f32x4*)(CN + 12 * 64 + 4 * c16);
#pragma unroll
        for (int reg = 0; reg < 4; ++reg) { float o[4];
#pragma unroll
            for (int ct = 0; ct < 4; ++ct) o[ct] = (y[ct][reg] * lw[ct] + lb[ct] + bon[reg] * vv[ct][reg]) * zg[ct][reg];
            u32x2 w; w.x = cvt_pk_bf16(o[0], o[1]); w.y = cvt_pk_bf16(o[2], o[3]);
            *(GAS u32x2*)(YR + (row0 + reg) * D + h * 64 + 4 * c16) = w; }
    }
}

__device__ __forceinline__ void scan_prompt_unit(Frame& F, int b, int h, bf16* YR) {
    LAS unsigned char* SC = F.lds + RING_OFF; const int w = F.wave, lane = F.lane;
    scan_load_head(F, SC, h);
    __syncthreads();
    f32x4 zt[4];
#pragma unroll
    for (int kb = 0; kb < 4; ++kb) zt[kb] = (f32x4){0.f, 0.f, 0.f, 0.f};
    LAS unsigned char* myslot = SC + SCAN_SLOT0 + w * SLOT_BYTES;
    const int g0 = b * SEQ;
    for (int s = 0; s < SEQ / 128; ++s) {
        const int T0 = (8 * s + w) * 16;
        float vv[4][4], zg[4][4], bon[4];
        LAS float* PV = (LAS float*)(SC + SCAN_PREV);
        produce_chunk(F, SC, myslot, h, g0, T0, 16, -1, (w == 0 && s > 0) ? PV + ((s - 1) & 1) * 384 : nullptr, w == 7 ? PV + (s & 1) * 384 : nullptr, vv, zg, bon);
        __syncthreads();
        if (w < 4) {
#pragma unroll 1
            for (int i = 0; i < 8; ++i) consume_chunk(SC + SCAN_SLOT0 + i * SLOT_BYTES, 16 * w, zt, lane);
        }
        __syncthreads();
        post_chunk(F, SC, myslot, h, (size_t)(g0 + T0 + 4 * (lane >> 4)), 16, vv, zg, bon, YR);
    }
    if (w < 4) { float* So = F.out + O_NRP + (size_t)(b * NH + h) * 4096; const int vl = lane & 15, q = lane >> 4;
#pragma unroll
        for (int reg = 0; reg < 4; ++reg) *(GAS f32x4*)(So + (4 * vl + w) * 64 + 16 * q + 4 * reg) = (f32x4){zt[0][reg], zt[1][reg], zt[2][reg], zt[3][reg]}; }
    __syncthreads();
}
__device__ __forceinline__ void scan_sample_units(Frame& F, int h, int bs, int nb, bf16* YR) {
    LAS unsigned char* SC = F.lds + RING_OFF; const int w = F.wave, lane = F.lane, vl = lane & 15, q = lane >> 4;
    scan_load_head(F, SC, h);
    __syncthreads();
    LAS unsigned char* myslot = SC + SCAN_SLOT0 + w * SLOT_BYTES;
    for (int bi = w; bi < nb; bi += NWAVES) {
        const int b = bs + bi, g0 = NPR + 4 * b;
        float vv[4][4], zg[4][4], bon[4];
        produce_chunk(F, SC, myslot, h, g0, 0, 4, NROW + b, nullptr, nullptr, vv, zg, bon);
        const float* S0 = F.state_rwkv + (size_t)(b * NH + h) * 4096; float* So = F.out + O_NRS + (size_t)(b * NH + h) * 4096;
#pragma unroll 1
        for (int cw = 0; cw < 4; ++cw) {
            f32x4 zt[4];
#pragma unroll
            for (int reg = 0; reg < 4; ++reg) { const f32x4 t = *(const GAS f32x4*)(S0 + (4 * vl + cw) * 64 + 16 * q + 4 * reg); zt[0][reg] = t[0]; zt[1][reg] = t[1]; zt[2][reg] = t[2]; zt[3][reg] = t[3]; }
            consume_chunk(myslot, 16 * cw, zt, lane);
#pragma unroll
            for (int reg = 0; reg < 4; ++reg) *(GAS f32x4*)(So + (4 * vl + cw) * 64 + 16 * q + 4 * reg) = (f32x4){zt[0][reg], zt[1][reg], zt[2][reg], zt[3][reg]};
        }
        post_chunk(F, SC, myslot, h, (size_t)(g0 + 4 * q), 4, vv, zg, bon, YR);
    }
    __syncthreads();
}
__device__ __forceinline__ void p2_scan(Frame& F, bf16* YR) {
    if (F.G == 256) {
        if (blockIdx.x < 128) scan_prompt_unit(F, blockIdx.x >> 4, blockIdx.x & 15, YR);
        else { const int sb = blockIdx.x - 128; scan_sample_units(F, sb & 15, (sb >> 4) * 16, 16, YR); }
    } else {
        for (int u = blockIdx.x; u < 128 + 128; u += F.G) {
            if (u < 128) scan_prompt_unit(F, u >> 4, u & 15, YR); else { const int sb = u - 128; scan_sample_units(F, sb & 15, (sb >> 4) * 16, 16, YR); }
        }
    }
}
__device__ __forceinline__ void p3_final_norm(Frame& F) {
    const int gw = blockIdx.x * NWAVES + F.wave, NGW = F.G * NWAVES;
    for (int m = gw; m < NROW; m += NGW) {
        GAS f32x4* xr = (GAS f32x4*)(F.out + O_Y + (size_t)m * D) + F.lane; const GAS f32x4* gr = (const GAS f32x4*)F.final_g + F.lane;
        const GAS f32x4* st = (const GAS f32x4*)(F.STATS + (size_t)m * 16);
        const f32x4 s0 = st[0], s1 = st[1], s2 = st[2], s3 = st[3];
        const float ss = ((s0.x + s0.y) + (s0.z + s0.w)) + ((s1.x + s1.y) + (s1.z + s1.w)) + ((s2.x + s2.y) + (s2.z + s2.w)) + ((s3.x + s3.y) + (s3.z + s3.w));
        const float rs = 1.0f / sqrtf(ss * (1.f / D) + RMS_EPS);
#pragma unroll
        for (int j = 0; j < 4; ++j) { const f32x4 v = xr[64 * j]; xr[64 * j] = (v * rs) * gr[64 * j]; }
    }
}

struct Args { const float* in[22]; float* out; unsigned char* ws; int ph_lo, ph_hi; };
__global__ void __launch_bounds__(NWAVES * 64, 2) mk_fwd(Args args) {
    extern __shared__ __attribute__((aligned(16))) unsigned char lds[];
    Frame F;
    F.lds = (LAS unsigned char*)lds;
    F.MISC = (volatile LAS unsigned*)(F.lds + MISC_OFF);
    F.tid = threadIdx.x; F.lane = F.tid & 63; F.wave = __builtin_amdgcn_readfirstlane(F.tid >> 6);
    F.G = gridDim.x;
    unsigned char* ws = args.ws;
    F.ctl = (gu32*)(ws + WS_CTL);
    F.x_prompt = args.in[0]; F.x_sample = args.in[1]; F.state_conv = args.in[2]; F.state_shift = args.in[3]; F.state_rwkv = args.in[4]; F.norm_g = args.in[5]; F.w_in = args.in[6];
    F.conv_w = args.in[7]; F.mu = args.in[8]; F.w0 = args.in[9]; F.w_up = args.in[10]; F.a0 = args.in[11]; F.a_up = args.in[12]; F.k_k = args.in[13]; F.k_a = args.in[14]; F.r_k = args.in[15];
    F.ln_w = args.in[16]; F.ln_b = args.in[17]; F.w_out_c = args.in[18]; F.w_out_r = args.in[19]; F.w_o = args.in[20]; F.final_g = args.in[21];
    F.out = args.out;
    F.Wt_in = (bf16*)(args.out + O_NRS); F.SGCp = (bf16*)(args.out + O_Y); F.SGRp = F.SGCp + (size_t)NPR * D;
    F.Wt_oc = (bf16*)(ws + WS_WOC); F.Wt_or = (bf16*)(ws + WS_WOR); F.Wt_o = (bf16*)(ws + WS_WO);
    F.STATS = (float*)(ws + WS_STATS); F.SGCs = (bf16*)(ws + WS_SGS); F.SGRs = F.SGCs + (size_t)NSR * D;
    F.H = (bf16*)(ws + WS_H); F.U = (bf16*)(ws + WS_U); F.GC = (bf16*)(ws + WS_GC); F.T1 = (float*)(ws + WS_U);
    F.R = (bf16*)(ws + WS_R); F.K = (bf16*)(ws + WS_K); F.V = (bf16*)(ws + WS_V); F.ZR = (bf16*)(ws + WS_ZR); F.WA = (bf16*)(ws + WS_WA);
    for (int u = F.tid; u < (LDS_BYTES - LDSCTL_OFF) / 4; u += NWAVES * 64) ((LAS unsigned*)(F.lds + LDSCTL_OFF))[u] = 0u;
    __syncthreads();
    XcdBarrier bar; bar.bar = (unsigned*)(F.ctl + CW_BAR); bar.x = 0; bar.st = nullptr;
    if (N_LAUNCHES == 1) bar = xcd_barrier_post((unsigned*)(F.ctl + CW_BAR), F.MISC + 8);
#define GRID_BAR() do { if (N_LAUNCHES == 1) xcd_barrier(bar); } while (0)
    const int lo = args.ph_lo, hi = args.ph_hi;
#define IN(k) (lo <= (k) && (k) < hi)
#define BOTH(k) (IN(k) && IN((k) + 1))

    if (IN(0)) { p0_prologue(F); if (PROBE_DUP & 1) p0_prologue(F); if (BOTH(0)) GRID_BAR(); }

    if (IN(1)) {
        pg8::Gemm g{F.H, F.Wt_in, NROWP, NT_IN * 256, D}; P1Order S{F.G, (int)blockIdx.x};
        EpiP1 E{F.U, F.GC, F.R, F.WA, F.SGCp, F.SGCs, F.out + O_NCP, F.out + O_NCS};
        pg8::gemm_phase<EpiP1, P1Order, true, true>(F.lds + RING_OFF, g, S, E);
        if (PROBE_DUP & 2) pg8::gemm_phase<EpiP1, P1Order, true, true>(F.lds + RING_OFF, g, S, E);
        if (BOTH(1)) GRID_BAR();
    }

    if (IN(2)) {
        if (F.G == 256) { if (blockIdx.x >= 128) { p2_convmix(F, blockIdx.x - 128, 128); if (PROBE_DUP & 4) p2_convmix(F, blockIdx.x - 128, 128); } }
        else p2_convmix(F, blockIdx.x, F.G);
        if (PROBE_DUP & 8) { GRID_BAR(); p2_scan(F, (bf16*)F.T1); }
        p2_scan(F, F.R); if (BOTH(2)) GRID_BAR(); }

    if (IN(3)) {
        pg8::Gemm g{F.H, F.Wt_oc, NROW, D, D}; pg8::StaticOrder S; S.init(NROW, D, F.G, (int)blockIdx.x);
        EpiT1 E{F.T1, F.SGCp, F.SGCs};
        pg8::gemm_phase<EpiT1, pg8::StaticOrder, true, true>(F.lds + RING_OFF, g, S, E);
        if (PROBE_DUP & 16) pg8::gemm_phase<EpiT1, pg8::StaticOrder, true, true>(F.lds + RING_OFF, g, S, E);
        if (BOTH(3)) GRID_BAR();
    }
    if (IN(4)) {
        pg8::Gemm g{F.R, F.Wt_or, NROW, D, D}; pg8::StaticOrder S; S.init(NROW, D, F.G, (int)blockIdx.x);
        EpiM E{F.T1, F.K, F.SGRp, F.SGRs};
        pg8::gemm_phase<EpiM, pg8::StaticOrder, true, true>(F.lds + RING_OFF, g, S, E);
        if (PROBE_DUP & 32) pg8::gemm_phase<EpiM, pg8::StaticOrder, true, true>(F.lds + RING_OFF, g, S, E);
        if (BOTH(4)) GRID_BAR();
    }
    if (IN(5)) {
        pg8::Gemm g{F.K, F.Wt_o, NROW, D, D}; pg8::StaticOrder S; S.init(NROW, D, F.G, (int)blockIdx.x);
        EpiXo E{F.x_prompt, F.x_sample, F.out + O_Y, F.STATS};
        pg8::gemm_phase<EpiXo, pg8::StaticOrder, true, true>(F.lds + RING_OFF, g, S, E);
        if (PROBE_DUP & 64) pg8::gemm_phase<EpiXo, pg8::StaticOrder, true, true>(F.lds + RING_OFF, g, S, E);
        if (BOTH(5)) GRID_BAR();
    }
    if (IN(6)) { p3_final_norm(F); }
#undef IN
#undef BOTH
}

extern "C" void kernel_launch(void* const* d_in, const int* in_sizes, int n_in, void* d_out, int out_size, void* d_ws, size_t ws_size, hipStream_t stream) {
    static int grid = 0;
    if (grid == 0) {
        if (n_in != 22 || in_sizes[0] != NPR * D || out_size != (int)O_END || ws_size < WS_END) {
            fprintf(stderr, "kernel_launch: unexpected shapes: n_in %d in0 %d out %d ws %zu; nothing launched\n", n_in, n_in > 0 ? in_sizes[0] : -1, out_size, ws_size); grid = -1; return; }
        int dev = 0, cus = 0, per_cu = 0;
        if (hipGetDevice(&dev) != hipSuccess || hipDeviceGetAttribute(&cus, hipDeviceAttributeMultiprocessorCount, dev) != hipSuccess) { fprintf(stderr, "kernel_launch: device query failed\n"); grid = -1; return; }
        if (hipFuncSetAttribute((const void*)mk_fwd, hipFuncAttributeMaxDynamicSharedMemorySize, LDS_BYTES) != hipSuccess) { fprintf(stderr, "kernel_launch: hipFuncSetAttribute failed\n"); grid = -1; return; }
        if (hipOccupancyMaxActiveBlocksPerMultiprocessor(&per_cu, (const void*)mk_fwd, NWAVES * 64, LDS_BYTES) != hipSuccess || per_cu < 1) { fprintf(stderr, "kernel_launch: occupancy query reports %d workgroups per CU\n", per_cu); per_cu = 1; }
        (void)hipGetLastError();
        grid = cus;
        if (grid > 256) grid = 256;
    }
    if (grid < 0) return;
    (void)hipMemsetAsync((char*)d_ws + WS_CTL, 0, CTL_ZERO_BYTES, stream);
    Args a{};
    for (int i = 0; i < 22; ++i) a.in[i] = (const float*)d_in[i];
    a.out = (float*)d_out; a.ws = (unsigned char*)d_ws;
    if (N_LAUNCHES == 1) { a.ph_lo = 0; a.ph_hi = N_PHASES; hipLaunchKernelGGL(mk_fwd, dim3(grid), dim3(NWAVES * 64), LDS_BYTES, stream, a); }
    else for (int li = 0; li < N_PHASES; ++li) { a.ph_lo = li; a.ph_hi = li + 1; hipLaunchKernelGGL(mk_fwd, dim3(grid), dim3(NWAVES * 64), LDS_BYTES, stream, a); }
}
```

```cpp
#include <hip/hip_runtime.h>
#include <cstdio>
#include <cstdint>
namespace pg8 {
#define PG8_LAS __attribute__((address_space(3)))
typedef unsigned short bf16_t;
typedef short bf16x8 __attribute__((ext_vector_type(8)));
typedef float f32x4 __attribute__((ext_vector_type(4)));
typedef unsigned u32x4 __attribute__((ext_vector_type(4)));
constexpr int BM = 256, BK = 64, HALF = 128, HTB = HALF * BK * 2  , STAGE_BYTES = 8 * HTB, NXCD = 8, WGM = 8;

__host__ __device__ __forceinline__ int lds_byte(int r, int c) { const int st = (r >> 4) * 2 + (c >> 5), rr = r & 15, cc = c & 31, ob = rr * 64 + cc * 2; return st * 1024 + (ob ^ (((ob >> 9) & 1) << 5)); }
__host__ __device__ __forceinline__ void stage_rc(int b, int& R, int& C) { const int st = b / 1024, sb = b % 1024, swz = sb ^ (((sb >> 9) & 1) << 5); R = (st >> 1) * 16 + swz / 64; C = (st & 1) * 32 + (swz % 64) / 2; }
__host__ __device__ __forceinline__ int perm32(int rho) { const int n = rho >> 4, i = rho & 15; return 8 * (i >> 2) + 4 * n + (i & 3); }

struct Unit { int pm, pn; };
struct Gemm { const bf16_t* A; const bf16_t* Bt; int M, N, K; };

struct StaticOrder {
    int nM, nN, nwg, G, c;
    __host__ __device__ void init(int M, int N, int G_, int c_) { nM = M / BM; nN = N / BM; nwg = nM * nN; G = G_; c = c_; }
    __host__ __device__ bool next(int i, Unit& u) const {
        const long L = (long)i * G + c; if (L >= nwg) return false;
        int wgid = (int)L; { const int q = nwg / NXCD, r = nwg % NXCD, xcd = wgid % NXCD, off = wgid / NXCD; wgid = (xcd < r ? xcd * (q + 1) : r * (q + 1) + (xcd - r) * q) + off; }
        const int nig = WGM * nN, gid = wgid / nig, fm = gid * WGM, gsz = (nM - fm) < WGM ? (nM - fm) : WGM;
        u.pm = fm + ((wgid % nig) % gsz); u.pn = (wgid % nig) / gsz; return true;
    }
    __device__ __forceinline__ void a_ready(const Unit&) const {}
    __device__ __forceinline__ void done(const Unit&) const {}
};

template <class Epi, class Sched, bool ALIGN_EPI = false, bool SP2 = false>
__device__ __forceinline__ void gemm_phase(PG8_LAS unsigned char* lds, const Gemm g, const Sched& S, const Epi& E) {
    const int tid = threadIdx.x, wid = __builtin_amdgcn_readfirstlane(tid >> 6), lane = tid & 63, wr = wid >> 2, wc = wid & 3, fr = lane & 15, fq = lane >> 4;
    const int K = g.K, nt = K / BK;
    unsigned voffA[2], voffB[2];
#pragma unroll
    for (int i = 0; i < 2; ++i) { int R, C; stage_rc(tid * 16 + i * 8192, R, C); const int Rb = Epi::PERM ? ((R & ~31) + perm32(R & 31)) : R;
        voffA[i] = (unsigned)(R * K + C) * 2u; voffB[i] = (unsigned)(Rb * K + C) * 2u; }
    const size_t kstep = (size_t)(BK * 2);
    const size_t hstep = (size_t)HALF * K * 2;
    const size_t tstep = 2 * hstep;
    const unsigned ldsw = (unsigned)wid * 1024u;
    const int aoff = lds_byte(wr * 64 + fr, fq * 8), boff = lds_byte(wc * 32 + fr, fq * 8);
#define PG8_SA(b, h) (((b) * 2 + (h)) * HTB)
#define PG8_SB(b, h) ((4 + (b) * 2 + (h)) * HTB)
#define PG8_STAGE(bufoff, gbase, voff) do { _Pragma("unroll") for (int _i = 0; _i < 2; ++_i) \
        __builtin_amdgcn_global_load_lds((const unsigned*)((const char*)(gbase) + (voff)[_i]), (PG8_LAS unsigned*)(lds + (bufoff) + ldsw + _i * 8192), 16, 0, 0); } while (0)
#define PG8_LDA(dst, b, h) do { _Pragma("unroll") for (int m = 0; m < 4; ++m) _Pragma("unroll") for (int k = 0; k < 2; ++k) dst[m][k] = *(const PG8_LAS bf16x8*)(lds + PG8_SA(b, h) + aoff + m * 2048 + k * 1024); } while (0)
#define PG8_LDB(dst, b, h) do { _Pragma("unroll") for (int n = 0; n < 2; ++n) _Pragma("unroll") for (int k = 0; k < 2; ++k) dst[n][k] = *(const PG8_LAS bf16x8*)(lds + PG8_SB(b, h) + boff + n * 2048 + k * 1024); } while (0)
#define PG8_MMA(ai, bj, At, Bt) do { __builtin_amdgcn_s_setprio(1); _Pragma("unroll") for (int m = 0; m < 4; ++m) _Pragma("unroll") for (int n = 0; n < 2; ++n) _Pragma("unroll") for (int k = 0; k < 2; ++k) \
        acc[ai][bj][m][n] = __builtin_amdgcn_mfma_f32_16x16x32_bf16(Bt[n][k], At[m][k], acc[ai][bj][m][n], 0, 0, 0); __builtin_amdgcn_s_setprio(0); } while (0)
#define PG8_WAIT_V(n) asm volatile("s_waitcnt vmcnt(" #n ")" ::: "memory")
#define PG8_WAIT_L(n) asm volatile("s_waitcnt lgkmcnt(" #n ")" ::: "memory")
#define PG8_BAR __builtin_amdgcn_s_barrier()
#define PG8_SCHED __builtin_amdgcn_sched_barrier(0)
    Unit cur, nxt; int ui = 0;
    if (!S.next(0, cur)) return;
    f32x4 acc[2][2][4][2];
#pragma unroll
    for (int a = 0; a < 2; ++a)
#pragma unroll
        for (int b = 0; b < 2; ++b)
#pragma unroll
            for (int m = 0; m < 4; ++m)
#pragma unroll
                for (int n = 0; n < 2; ++n) acc[a][b][m][n] = (f32x4){0.f, 0.f, 0.f, 0.f};
    bf16x8 At[4][2], B0[2][2], B1[2][2];
    const char* cA = (const char*)g.A + (size_t)cur.pm * tstep; const char* cB = (const char*)g.Bt + (size_t)cur.pn * tstep;
    S.a_ready(cur);
    if constexpr (SP2) {
        PG8_STAGE(PG8_SB(0, 0), cB, voffB); PG8_STAGE(PG8_SB(0, 1), cB + hstep, voffB); PG8_STAGE(PG8_SA(0, 0), cA, voffA); PG8_STAGE(PG8_SA(0, 1), cA + hstep, voffA);
        if (wr == 1) PG8_BAR;
        PG8_WAIT_V(2); PG8_BAR;
        PG8_STAGE(PG8_SB(1, 0), cB + kstep, voffB); PG8_STAGE(PG8_SA(1, 0), cA + kstep, voffA); PG8_STAGE(PG8_SB(1, 1), cB + hstep + kstep, voffB);
        PG8_WAIT_V(6); PG8_BAR;
    } else {
        PG8_STAGE(PG8_SB(0, 0), cB, voffB); PG8_STAGE(PG8_SA(0, 0), cA, voffA); PG8_STAGE(PG8_SB(0, 1), cB + hstep, voffB); PG8_STAGE(PG8_SA(0, 1), cA + hstep, voffA);
        if (wr == 1) PG8_BAR;
        PG8_WAIT_V(4); PG8_BAR;
        PG8_STAGE(PG8_SB(1, 0), cB + kstep, voffB); PG8_STAGE(PG8_SA(1, 0), cA + kstep, voffA); PG8_STAGE(PG8_SB(1, 1), cB + hstep + kstep, voffB);
        PG8_WAIT_V(6); PG8_BAR;
    }
    for (;;) {
        const bool has_next = S.next(ui + 1, nxt);
        const char* nA = has_next ? (const char*)g.A + (size_t)nxt.pm * tstep : cA; const char* nB = has_next ? (const char*)g.Bt + (size_t)nxt.pn * tstep : cB;
        for (int t = 0; t < nt; t += 2) {
            const bool last = (t == nt - 2);
            const char* a1 = cA + (size_t)(t + 1) * kstep;
            const char* a2 = last ? nA : cA + (size_t)(t + 2) * kstep; const char* b2 = last ? nB : cB + (size_t)(t + 2) * kstep;
            const char* a3 = a2 + kstep; const char* b3 = b2 + kstep;
            if (last && has_next) S.a_ready(nxt);
            if constexpr (SP2) {
            PG8_LDB(B0, 0, 0); PG8_LDB(B1, 0, 1); PG8_SCHED; PG8_LDA(At, 0, 0); PG8_STAGE(PG8_SA(1, 1), a1 + hstep, voffA);
            PG8_WAIT_V(8); PG8_WAIT_L(0); PG8_BAR; PG8_MMA(0, 0, At, B0); PG8_MMA(0, 1, At, B1); PG8_BAR; PG8_SCHED;
            PG8_LDA(At, 0, 1); PG8_STAGE(PG8_SB(0, 0), b2, voffB); PG8_STAGE(PG8_SB(0, 1), b2 + hstep, voffB); PG8_STAGE(PG8_SA(0, 0), a2, voffA);
            PG8_WAIT_V(8); PG8_WAIT_L(0); PG8_BAR; PG8_MMA(1, 0, At, B0); PG8_MMA(1, 1, At, B1); PG8_BAR; PG8_SCHED;
            PG8_LDB(B0, 1, 0); PG8_LDB(B1, 1, 1); PG8_SCHED; PG8_LDA(At, 1, 0); PG8_STAGE(PG8_SA(0, 1), a2 + hstep, voffA);
            PG8_WAIT_V(8); PG8_WAIT_L(0); PG8_BAR; PG8_MMA(0, 0, At, B0); PG8_MMA(0, 1, At, B1); PG8_BAR; PG8_SCHED;
            PG8_LDA(At, 1, 1); PG8_STAGE(PG8_SB(1, 0), b3, voffB); PG8_STAGE(PG8_SB(1, 1), b3 + hstep, voffB); PG8_STAGE(PG8_SA(1, 0), a3, voffA);
            PG8_WAIT_V(8); PG8_WAIT_L(0); PG8_BAR; PG8_MMA(1, 0, At, B0); PG8_MMA(1, 1, At, B1); PG8_BAR; PG8_SCHED;
            } else {
            PG8_LDB(B0, 0, 0); PG8_SCHED; PG8_LDA(At, 0, 0); PG8_STAGE(PG8_SA(1, 1), a1 + hstep, voffA);
            PG8_WAIT_L(8); PG8_BAR; PG8_WAIT_L(0); PG8_MMA(0, 0, At, B0); PG8_BAR; PG8_SCHED;
            PG8_LDB(B1, 0, 1); PG8_STAGE(PG8_SB(0, 0), b2, voffB);
            PG8_BAR; PG8_WAIT_L(0); PG8_MMA(0, 1, At, B1); PG8_BAR;
            PG8_LDA(At, 0, 1); PG8_STAGE(PG8_SA(0, 0), a2, voffA);
            PG8_BAR; PG8_WAIT_L(0); PG8_MMA(1, 0, At, B0); PG8_BAR; PG8_SCHED;
            PG8_STAGE(PG8_SB(0, 1), b2 + hstep, voffB);
            PG8_WAIT_V(6); PG8_BAR; PG8_MMA(1, 1, At, B1); PG8_BAR;
            PG8_LDB(B0, 1, 0); PG8_SCHED; PG8_LDA(At, 1, 0); PG8_STAGE(PG8_SA(0, 1), a2 + hstep, voffA);
            PG8_WAIT_L(8); PG8_BAR; PG8_WAIT_L(0); PG8_MMA(0, 0, At, B0); PG8_BAR; PG8_SCHED;
            PG8_LDB(B1, 1, 1); PG8_STAGE(PG8_SB(1, 0), b3, voffB);
            PG8_BAR; PG8_WAIT_L(0); PG8_MMA(0, 1, At, B1); PG8_BAR;
            PG8_LDA(At, 1, 1); PG8_STAGE(PG8_SA(1, 0), a3, voffA);
            PG8_BAR; PG8_WAIT_L(0); PG8_MMA(1, 0, At, B0); PG8_BAR; PG8_SCHED;
            PG8_STAGE(PG8_SB(1, 1), b3 + hstep, voffB);
            PG8_WAIT_V(6); PG8_BAR; PG8_MMA(1, 1, At, B1); PG8_BAR;
            }
        }
        if constexpr (ALIGN_EPI) { if (wr == 0) PG8_BAR; }
        if constexpr (!Epi::AFTER_DRAIN) { E(acc, cur, wr, wc, fr, fq); S.done(cur); }
        if (!has_next) break;
#pragma unroll
        for (int a = 0; a < 2; ++a)
#pragma unroll
            for (int b = 0; b < 2; ++b)
#pragma unroll
                for (int m = 0; m < 4; ++m)
#pragma unroll
                    for (int n = 0; n < 2; ++n) acc[a][b][m][n] = (f32x4){0.f, 0.f, 0.f, 0.f};
        cur = nxt; cA = nA; cB = nB; ++ui;
        if constexpr (ALIGN_EPI) { if (wr == 1) PG8_BAR; }
    }
    PG8_WAIT_V(0);
    if constexpr (!ALIGN_EPI) { if (wr == 0) PG8_BAR; }
    PG8_BAR;
    if constexpr (Epi::AFTER_DRAIN) { E.fused(acc, cur, wr, wc, fr, fq, lds, wid, lane); S.done(cur); }
#undef PG8_SA
#undef PG8_SB
#undef PG8_STAGE
#undef PG8_LDA
#undef PG8_LDB
#undef PG8_MMA
#undef PG8_WAIT_V
#undef PG8_WAIT_L
#undef PG8_BAR
#undef PG8_SCHED
}
}
#define GAS __attribute__((address_space(1)))
#define LAS __attribute__((address_space(3)))
typedef unsigned short bf16;
typedef unsigned v4u __attribute__((ext_vector_type(4)));
typedef float f32x4 __attribute__((ext_vector_type(4)));
typedef short bf16x8 __attribute__((ext_vector_type(8)));
typedef GAS unsigned gu32;
typedef GAS unsigned long long gu64;
#define RLX_AGENT __ATOMIC_RELAXED, __HIP_MEMORY_SCOPE_AGENT
#define LDS_WAIT() asm volatile("s_waitcnt lgkmcnt(0)" ::: "memory")
#define VM_WAIT() asm volatile("s_waitcnt vmcnt(0)" ::: "memory")
__device__ __forceinline__ unsigned long long rt() { return __builtin_amdgcn_s_memrealtime(); }
__device__ __forceinline__ unsigned f2bf(float f) { unsigned u = __builtin_bit_cast(unsigned, f); return (u + 0x7fffu + ((u >> 16) & 1u)) >> 16; }
__device__ __forceinline__ unsigned pk2(float lo, float hi) { return f2bf(lo) | (f2bf(hi) << 16); }

#define XB_TMO      128
#define XB_XCNT(j)  (256  + 64 * (j))
#define XB_XSUB(j)  (1280 + 64 * (j))
#define XB_XGEN(j)  (2304 + 64 * (j))
#define XB_TOP      3328
#define XB_TOPGEN   3392
#define XCD_BAR_WORDS 3456
#define XB_SPIN_CAP (1u << 18)

__device__ __forceinline__ unsigned xb_ld(unsigned* p)              { return __hip_atomic_load(p, __ATOMIC_RELAXED, __HIP_MEMORY_SCOPE_AGENT); }
__device__ __forceinline__ unsigned xb_add(unsigned* p, unsigned v) { return __hip_atomic_fetch_add(p, v, __ATOMIC_RELAXED, __HIP_MEMORY_SCOPE_AGENT); }
__device__ __forceinline__ unsigned xb_xcc_id() { return (unsigned)__builtin_amdgcn_s_getreg((3 << 11) | 20) & 0xFu; }
#define XB_SPIN(cond, bar) do { unsigned _sp = 0; while (cond) { __builtin_amdgcn_s_sleep(1); \
    if ((++_sp & 255u) == 0u) { if (xb_ld(&(bar)[XB_TMO])) break; if (_sp > XB_SPIN_CAP) { atomicAdd(&(bar)[XB_TMO], 1u); break; } } } } while (0)

struct XcdBarrier {
    unsigned* bar; unsigned x;
    volatile LAS unsigned* st;
};

__device__ __forceinline__ XcdBarrier xcd_barrier_post(unsigned* bar, volatile LAS unsigned* st) {
    XcdBarrier b; b.bar = bar; b.x = xb_xcc_id(); b.st = st;
    if (threadIdx.x == 0) (void)xb_add(&bar[XB_XCNT(b.x)], 1u);
    return b;
}
__device__ __forceinline__ void xcd_barrier_complete(unsigned* bar, unsigned x, unsigned& nloc, unsigned& nx) {
    const unsigned G = gridDim.x * gridDim.y * gridDim.z;
    unsigned sum, cnt, mine, sp = 0u;
    for (;;) {
        sum = 0u; cnt = 0u; mine = 0u;
#pragma unroll
        for (unsigned j = 0; j < 16; ++j) { const unsigned c = xb_ld(&bar[XB_XCNT(j)]); sum += c; cnt += (c > 0u) ? 1u : 0u; mine = (j == x) ? c : mine; }
        if (sum == G) break;
        __builtin_amdgcn_s_sleep(1);
        if ((++sp & 255u) == 0u) { if (xb_ld(&bar[XB_TMO])) break; if (sp > XB_SPIN_CAP) { atomicAdd(&bar[XB_TMO], 1u); break; } }
    }
    nloc = mine > 0u ? mine : 1u; nx = cnt > 0u ? cnt : 1u;
}

__device__ __forceinline__ void xcd_barrier(const XcdBarrier& b) {
    asm volatile("s_waitcnt vmcnt(0)" ::: "memory");
    __syncthreads();
    if (threadIdx.x == 0) {
        unsigned* bar = b.bar;
        __builtin_amdgcn_s_waitcnt(0);
        unsigned nloc = b.st[0], nx = b.st[1];
        if (nloc == 0u) { xcd_barrier_complete(bar, b.x, nloc, nx); b.st[0] = nloc; b.st[1] = nx; }
        const unsigned old = xb_add(&bar[XB_XSUB(b.x)], 1u);
        const unsigned gen = old / nloc;
        if (old + 1u == (gen + 1u) * nloc) {
            __builtin_amdgcn_fence(__ATOMIC_RELEASE, "agent");
            asm volatile("s_waitcnt vmcnt(0)" ::: "memory");
            const unsigned og = xb_add(&bar[XB_TOP], 1u);
            const unsigned tg = og / nx;
            if (og + 1u == (tg + 1u) * nx) xb_add(&bar[XB_TOPGEN], 1u);
            else XB_SPIN(xb_ld(&bar[XB_TOPGEN]) == tg, bar);
            __builtin_amdgcn_fence(__ATOMIC_ACQUIRE, "agent");
            xb_add(&bar[XB_XGEN(b.x)], 1u);
            asm volatile("s_waitcnt vmcnt(0)" ::: "memory");
        } else {
            XB_SPIN(xb_ld(&bar[XB_XGEN(b.x)]) == gen, bar);
            __builtin_amdgcn_fence(__ATOMIC_ACQUIRE, "agent");
            asm volatile("s_waitcnt vmcnt(0)" ::: "memory");
        }
    }
    __syncthreads();
}

constexpr int NWAVES = 8;
constexpr int D = 1024, NPR = 16384, NSR = 512, NROW = NPR + NSR, NROWP = 17152;
constexpr int SEQ = 2048, DBATCH = 128, NH = 16;
constexpr int N_IN = 10368, NT_IN = 41;
constexpr float RMS_EPS = 1e-6f, GN_EPS = 64e-5f;
#ifndef MK_N_LAUNCHES
#define MK_N_LAUNCHES 1
#endif
constexpr int N_PHASES = 6;
#ifndef PROBE_SCAN
#define PROBE_SCAN -1
#endif
#ifndef PROBE_DUP
#define PROBE_DUP 0
#endif
constexpr int N_LAUNCHES = MK_N_LAUNCHES;

constexpr size_t MiB = 1u << 20;
constexpr size_t WS_CTL = 0, CTL_ZERO_BYTES = 64 * 1024;
constexpr size_t WS_WOC = 1 * MiB, WS_WOR = 3 * MiB, WS_WO = 5 * MiB;
constexpr size_t WS_STATS = 7 * MiB;
constexpr size_t WS_SGS = 9 * MiB;
constexpr size_t WS_H = 11 * MiB;
constexpr size_t WS_U = 45 * MiB, WS_GC = 78 * MiB;
constexpr size_t WS_R = 111 * MiB, WS_K = 145 * MiB, WS_V = 179 * MiB, WS_ZR = 213 * MiB;
constexpr size_t WS_WA = 247 * MiB;
constexpr size_t WS_END = 256 * MiB;
constexpr size_t RKVZ_STRIDE = (WS_K - WS_R) / 2;
static_assert(WS_V - WS_K == WS_K - WS_R && WS_ZR - WS_V == WS_K - WS_R, "R|K|V|ZR equally spaced");
static_assert(WS_H + (size_t)NROWP * D * 2 <= WS_U && WS_U + (size_t)NROW * D * 2 <= WS_GC && WS_GC + (size_t)NROW * D * 2 <= WS_R && WS_U + (size_t)NROW * D * 4 <= WS_R, "ws map 1");
static_assert(WS_R + (size_t)NROWP * D * 2 <= WS_K && WS_ZR + (size_t)NROWP * D * 2 <= WS_WA && WS_WA + (size_t)NROWP * 256 * 2 <= WS_END, "ws map 2");
constexpr size_t O_Y = 0, O_NCP = 17301504, O_NSP = 17317888, O_NRP = 17326080, O_NCS = 17850368, O_NSS = 18112512, O_NRS = 18243584, O_END = 26632192;
static_assert((size_t)NT_IN * 256 * D * 2 <= (O_END - O_NRS) * 4, "Wt_in fits in the new_rwkv_sample region");
constexpr int CW_BAR = 4096;
constexpr int CW_TMO = 0, CW_HB0 = 64, CW_HB1 = 128, CW_HB2 = 192;

constexpr int RING_OFF = 0, RING_BYTES = 131072;
constexpr int LDSCTL_OFF = 162816, MISC_OFF = LDSCTL_OFF + 320;
constexpr int LDS_BYTES = 163840;

typedef unsigned u32x2 __attribute__((ext_vector_type(2)));
__device__ __forceinline__ float bf2f(unsigned short h) { return __uint_as_float((unsigned)h << 16); }
__device__ __forceinline__ float bflo(unsigned w) { return __uint_as_float(w << 16); }
__device__ __forceinline__ float bfhi(unsigned w) { return __uint_as_float(w & 0xffff0000u); }
__device__ __forceinline__ float sigmoidf_(float x) { return __builtin_amdgcn_rcpf(1.0f + __expf(-x)); }
__device__ __forceinline__ float wave_sum(float v) {
#pragma unroll
    for (int o = 1; o < 64; o <<= 1) v += __shfl_xor(v, o);
    return v;
}
__host__ __device__ __forceinline__ int col2slot(int c) { return (c & ~31) | (((c >> 2) & 1) << 4) | (((c >> 3) & 3) << 2) | (c & 3); }
__device__ __forceinline__ int win_dst_row(int n) {
    if (n < 4096) { const int g = n >> 10, ch = n & 1023, pn = ch >> 6, cl = ch & 63;
        return pn * 256 + ((g >> 1) << 7) + ((cl >> 4) << 5) + ((g & 1) << 4) + (cl & 15); }
    if (n < 7168) { const int cc = n - 4096; return (16 + (cc >> 8)) * 256 + col2slot(cc & 255); }
    if (n < 7296) return 32 * 256 + col2slot(n - 7168);
    if (n < 8320) { const int cc = n - 7296; return (28 + (cc >> 8)) * 256 + col2slot(cc & 255); }
    { const int cc = n - 8320; return (33 + (cc >> 8)) * 256 + col2slot(cc & 255); }
}

struct P1Order {
    int G, c;
    __device__ __forceinline__ bool next(int i, pg8::Unit& u) const {
        constexpr int nM = 66, nN = NT_IN, nwg = nM * nN;
        const int L = i * G + c; if (L >= nwg + 17) return false;
        if (L >= nwg) { u.pm = 66; u.pn = 16 + (L - nwg); return true; }
        int wgid = L; { const int q = nwg / 8, r = nwg % 8, xcd = wgid % 8, off = wgid / 8; wgid = (xcd < r ? xcd * (q + 1) : r * (q + 1) + (xcd - r) * q) + off; }
        const int nig = 8 * nN, gid = wgid / nig, fm = gid * 8, gsz = (nM - fm) < 8 ? (nM - fm) : 8;
        u.pm = fm + ((wgid % nig) % gsz); u.pn = (wgid % nig) / gsz; return true;
    }
    __device__ __forceinline__ void a_ready(const pg8::Unit&) const {}
    __device__ __forceinline__ void done(const pg8::Unit&) const {}
};

typedef v4u u32x4; typedef bf16 bf16_t;
__device__ __forceinline__ unsigned cvt_pk_bf16(float lo, float hi) { unsigned r; asm volatile("v_cvt_pk_bf16_f32 %0, %1, %2" : "=v"(r) : "v"(lo), "v"(hi)); return r; }
__device__ __forceinline__ u32x4 pack8(const f32x4 v0, const f32x4 v1) { u32x4 w; w.x = cvt_pk_bf16(v0[0], v0[1]); w.y = cvt_pk_bf16(v0[2], v0[3]); w.z = cvt_pk_bf16(v1[0], v1[1]); w.w = cvt_pk_bf16(v1[2], v1[3]); return w; }

struct EpiP1 {
    static constexpr bool PERM = false, AFTER_DRAIN = false;
    bf16_t *U, *GC, *R, *WA, *SGCp, *SGCs; float *ncp, *ncs;
    __device__ __forceinline__ void operator()(const f32x4 (&acc)[2][2][4][2], const pg8::Unit& u, int wr, int wc, int fr, int fq) const {
        const int row0 = u.pm * 256 + wr * 64 + fr;
        if (u.pn < 16) {
            const int ch = u.pn * 64 + wc * 16 + fq * 4;
#pragma unroll
            for (int ai = 0; ai < 2; ++ai)
#pragma unroll
                for (int m = 0; m < 4; ++m) {
                    const int row = row0 + ai * 128 + m * 16;
                    const f32x4 xin = acc[ai][0][m][0], bg = acc[ai][0][m][1], cg = acc[ai][1][m][0], zc = acc[ai][1][m][1];
                    f32x4 uu, gg;
#pragma unroll
                    for (int j = 0; j < 4; ++j) { uu[j] = cg[j] * xin[j]; gg[j] = bg[j] * zc[j] * sigmoidf_(zc[j]); }
                    u32x2 wu, wg; wu.x = cvt_pk_bf16(uu[0], uu[1]); wu.y = cvt_pk_bf16(uu[2], uu[3]); wg.x = cvt_pk_bf16(gg[0], gg[1]); wg.y = cvt_pk_bf16(gg[2], gg[3]);
                    *(u32x2*)(U + (size_t)row * D + ch) = wu; *(u32x2*)(GC + (size_t)row * D + ch) = wg;
                    if (row < NPR) { const int t = row & (SEQ - 1); if (t >= SEQ - 2) *(f32x4*)(ncp + ((size_t)(row >> 11) * 2 + (t - (SEQ - 2))) * D + ch) = uu; }
                    else { const int rs = row - NPR, t = rs & 3; if (t >= 2) *(f32x4*)(ncs + ((size_t)(rs >> 2) * 2 + (t - 2)) * D + ch) = uu; }
                }
            return;
        }
        bf16_t* base; int ldc = D, colt; bool sig = false;
        if (u.pn < 32) { const int g = (u.pn - 16) >> 2; base = R + (size_t)g * RKVZ_STRIDE; colt = ((u.pn - 16) & 3) * 256; }
        else if (u.pn == 32) { base = WA; ldc = 256; colt = 0; }
        else { sig = true; const int g = (u.pn - 33) >> 2; colt = ((u.pn - 33) & 3) * 256;
               if (u.pm < 64) base = SGCp + (size_t)g * NPR * D; else base = SGCs + (size_t)g * NSR * D - (size_t)NPR * D; }
        const int col0 = colt + wc * 32 + 8 * fq;
#pragma unroll
        for (int ai = 0; ai < 2; ++ai)
#pragma unroll
            for (int m = 0; m < 4; ++m) { bf16_t* rowp = base + (size_t)(row0 + ai * 128 + m * 16) * ldc + col0;
#pragma unroll
                for (int bj = 0; bj < 2; ++bj) { f32x4 v0 = acc[ai][bj][m][0], v1 = acc[ai][bj][m][1];
                    if (sig) {
#pragma unroll
                        for (int j = 0; j < 4; ++j) { v0[j] = sigmoidf_(v0[j]); v1[j] = sigmoidf_(v1[j]); } }
                    *(u32x4*)(rowp + bj * 128) = pack8(v0, v1); } }
    }
};
__device__ __forceinline__ void unpack8(const u32x4 w, f32x4& a, f32x4& b) { a[0] = bflo(w.x); a[1] = bfhi(w.x); a[2] = bflo(w.y); a[3] = bfhi(w.y); b[0] = bflo(w.z); b[1] = bfhi(w.z); b[2] = bflo(w.w); b[3] = bfhi(w.w); }
struct EpiT1 {
    static constexpr bool PERM = false, AFTER_DRAIN = false;
    float* T1; const bf16_t *SGp, *SGs;
    __device__ __forceinline__ void operator()(const f32x4 (&acc)[2][2][4][2], const pg8::Unit& u, int wr, int wc, int fr, int fq) const {
        const int row0 = u.pm * 256 + wr * 64 + fr, col0 = u.pn * 256 + wc * 32 + 8 * fq;
        const bf16_t* sg = u.pm < 64 ? SGp : SGs - (size_t)NPR * D;
#pragma unroll
        for (int ai = 0; ai < 2; ++ai)
#pragma unroll
            for (int m = 0; m < 4; ++m) { const size_t off = (size_t)(row0 + ai * 128 + m * 16) * D + col0;
#pragma unroll
                for (int bj = 0; bj < 2; ++bj) { f32x4 g0, g1; unpack8(*(const u32x4*)(sg + off + bj * 128), g0, g1);
                    *(f32x4*)(T1 + off + bj * 128) = acc[ai][bj][m][0] * g0; *(f32x4*)(T1 + off + bj * 128 + 4) = acc[ai][bj][m][1] * g1; } }
    }
};
struct EpiM {
    static constexpr bool PERM = false, AFTER_DRAIN = false;
    const float* T1; bf16_t* M; const bf16_t *SGp, *SGs;
    __device__ __forceinline__ void operator()(const f32x4 (&acc)[2][2][4][2], const pg8::Unit& u, int wr, int wc, int fr, int fq) const {
        const int row0 = u.pm * 256 + wr * 64 + fr, col0 = u.pn * 256 + wc * 32 + 8 * fq;
        const bf16_t* sg = u.pm < 64 ? SGp : SGs - (size_t)NPR * D;
#pragma unroll
        for (int ai = 0; ai < 2; ++ai)
#pragma unroll
            for (int m = 0; m < 4; ++m) { const size_t off = (size_t)(row0 + ai * 128 + m * 16) * D + col0;
#pragma unroll
                for (int bj = 0; bj < 2; ++bj) { f32x4 g0, g1; unpack8(*(const u32x4*)(sg + off + bj * 128), g0, g1);
                    const f32x4 t0 = *(const f32x4*)(T1 + off + bj * 128), t1 = *(const f32x4*)(T1 + off + bj * 128 + 4);
                    *(u32x4*)(M + off + bj * 128) = pack8(t0 + acc[ai][bj][m][0] * g0, t1 + acc[ai][bj][m][1] * g1); } }
    }
};
struct EpiXo {
    static constexpr bool PERM = false, AFTER_DRAIN = false;
    const float *xp, *xs; float* out; float* stats;
    __device__ __forceinline__ void operator()(const f32x4 (&acc)[2][2][4][2], const pg8::Unit& u, int wr, int wc, int fr, int fq) const {
        const int row0 = u.pm * 256 + wr * 64 + fr, col0 = u.pn * 256 + wc * 32 + 8 * fq;
        const float* x = u.pm < 64 ? xp : xs - (size_t)NPR * D;
#pragma unroll
        for (int ai = 0; ai < 2; ++ai)
#pragma unroll
            for (int m = 0; m < 4; ++m) { const int row = row0 + ai * 128 + m * 16; const size_t off = (size_t)row * D + col0; float ss = 0.f;
#pragma unroll
                for (int bj = 0; bj < 2; ++bj) {
                    const f32x4 o0 = *(const f32x4*)(x + off + bj * 128) + acc[ai][bj][m][0], o1 = *(const f32x4*)(x + off + bj * 128 + 4) + acc[ai][bj][m][1];
                    *(f32x4*)(out + off + bj * 128) = o0; *(f32x4*)(out + off + bj * 128 + 4) = o1;
                    ss += (o0[0] * o0[0] + o0[1] * o0[1]) + (o0[2] * o0[2] + o0[3] * o0[3]) + (o1[0] * o1[0] + o1[1] * o1[1]) + (o1[2] * o1[2] + o1[3] * o1[3]); }
                ss += __shfl_xor(ss, 16); ss += __shfl_xor(ss, 32);
                if (fq == 0) stats[(size_t)row * 16 + u.pn * 4 + wc] = ss; }
    }
};

struct Frame {
    LAS unsigned char* lds;
    volatile LAS unsigned* MISC;
    gu32* ctl;
    int tid, lane, wave, G;
    const float *x_prompt, *x_sample, *state_conv, *state_shift, *state_rwkv, *norm_g, *w_in, *conv_w, *mu, *w0, *w_up, *a0, *a_up, *k_k, *k_a, *r_k, *ln_w, *ln_b, *w_out_c, *w_out_r, *w_o, *final_g;
    float* out;
    bf16 *Wt_in, *Wt_oc, *Wt_or, *Wt_o, *H, *U, *GC, *R, *K, *V, *ZR, *WA, *SGCp, *SGRp, *SGCs, *SGRs;
    float *T1, *STATS;
};

template <class DST>
__device__ __forceinline__ void p0_transpose_item(const float* W, int K, int N, bf16* WT, LAS float* scr, int item, int lane, DST dst) {
    const int nblk = N / 32, kb = item / nblk, nb = item % nblk, k0 = 64 * kb, n0 = 32 * nb;
#pragma unroll 8
    for (int i = 0; i < 32; ++i) { const int kk = 2 * i + (lane >> 5); scr[kk * 33 + (lane & 31)] = W[(size_t)(k0 + kk) * N + n0 + (lane & 31)]; }
    LDS_WAIT(); asm volatile("" ::: "memory");
    const int c = lane & 7;
#pragma unroll
    for (int j = 0; j < 4; ++j) { const int n = (lane >> 3) + 8 * j; const LAS float* s = scr + (8 * c) * 33 + n;
        v4u o; o.x = pk2(s[0 * 33], s[1 * 33]); o.y = pk2(s[2 * 33], s[3 * 33]); o.z = pk2(s[4 * 33], s[5 * 33]); o.w = pk2(s[6 * 33], s[7 * 33]);
        *(GAS v4u*)(WT + (size_t)dst(n0 + n) * K + k0 + 8 * c) = o; }
    LDS_WAIT(); asm volatile("" ::: "memory");
}
struct DstIn { __device__ __forceinline__ int operator()(int n) const { return win_dst_row(n); } };
struct DstSlot { __device__ __forceinline__ int operator()(int n) const { return col2slot(n); } };

__device__ __forceinline__ void rms_row(Frame& F, const float* xrow, const float* g, bf16* orow, float* f32row) {
    const GAS f32x4* xr = (const GAS f32x4*)xrow + F.lane; const GAS f32x4* gr = (const GAS f32x4*)g + F.lane;
    f32x4 v[4]; float s = 0.f;
#pragma unroll
    for (int j = 0; j < 4; ++j) { v[j] = xr[64 * j]; s += (v[j].x * v[j].x + v[j].y * v[j].y) + (v[j].z * v[j].z + v[j].w * v[j].w); }
    const float rs = 1.0f / sqrtf(wave_sum(s) * (1.f / D) + RMS_EPS);
    GAS unsigned long long* o8 = (GAS unsigned long long*)orow + F.lane;
#pragma unroll
    for (int j = 0; j < 4; ++j) { const f32x4 y = (v[j] * rs) * gr[64 * j];
        o8[64 * j] = (unsigned long long)pk2(y.x, y.y) | ((unsigned long long)pk2(y.z, y.w) << 32);
        if (f32row) ((GAS f32x4*)f32row)[64 * j + F.lane] = y; }
}
__device__ __forceinline__ void p0_prologue(Frame& F) {
    LAS float* scr = (LAS float*)(F.lds + RING_OFF + F.wave * 16384);
    const int gw = blockIdx.x * NWAVES + F.wave, NGW = F.G * NWAVES;
    constexpr int I_IN = (D / 64) * (N_IN / 32), I_SQ = (D / 64) * (D / 32);
    constexpr int NITEMS = I_IN + 3 * I_SQ;
    for (int it = gw; it < NITEMS; it += NGW) {
        int r = it;
        if (r < I_IN) { p0_transpose_item(F.w_in, D, N_IN, F.Wt_in, scr, r, F.lane, DstIn()); continue; } r -= I_IN;
        if (r < I_SQ) { p0_transpose_item(F.w_out_c, D, D, F.Wt_oc, scr, r, F.lane, DstSlot()); continue; } r -= I_SQ;
        if (r < I_SQ) { p0_transpose_item(F.w_out_r, D, D, F.Wt_or, scr, r, F.lane, DstSlot()); continue; } r -= I_SQ;
        p0_transpose_item(F.w_o, D, D, F.Wt_o, scr, r, F.lane, DstSlot());
    }
    for (int m = gw; m < 256; m += NGW) { bf16* p = m < 128 ? F.Wt_in + (size_t)(32 * 256 + 128 + m) * D : F.H + (size_t)(NROW + 128 + (m - 128)) * D;
        GAS v4u* o = (GAS v4u*)p + F.lane; o[0] = (v4u){0u, 0u, 0u, 0u}; o[64] = (v4u){0u, 0u, 0u, 0u}; }
    for (int m = gw; m < NROW + DBATCH; m += NGW) {
        if (m < NPR) { const int t = m & (SEQ - 1); rms_row(F, F.x_prompt + (size_t)m * D, F.norm_g, F.H + (size_t)m * D, t == SEQ - 1 ? F.out + O_NSP + (size_t)(m >> 11) * D : nullptr); }
        else if (m < NROW) { const int rs = m - NPR; rms_row(F, F.x_sample + (size_t)rs * D, F.norm_g, F.H + (size_t)m * D, (rs & 3) == 3 ? F.out + O_NSS + (size_t)(rs >> 2) * D : nullptr); }
        else { const GAS f32x4* xr = (const GAS f32x4*)(F.state_shift + (size_t)(m - NROW) * D) + F.lane; GAS unsigned long long* o8 = (GAS unsigned long long*)(F.H + (size_t)m * D) + F.lane;
#pragma unroll
            for (int j = 0; j < 4; ++j) { const f32x4 y = xr[64 * j]; o8[64 * j] = (unsigned long long)pk2(y.x, y.y) | ((unsigned long long)pk2(y.z, y.w) << 32); } }
    }
}

__device__ __forceinline__ void p2_convmix(Frame& F, int part, int nparts) {
    bf16* YC = F.H;
    const int gt = part * (NWAVES * 64) + F.tid, NT = nparts * NWAVES * 64;
    for (int it = gt; it < NROW * 128; it += NT) {
        const int row = it >> 7, ch = (it & 127) * 8;
        int tis, b = 0; if (row < NPR) tis = row & (SEQ - 1); else { const int rs = row - NPR; tis = rs & 3; b = rs >> 2; }
        const bool smp = row >= NPR;
        f32x4 u0a, u0b, u1a, u1b, u2a, u2b, ga, gb;
        unpack8(*(const GAS v4u*)(F.U + (size_t)row * D + ch), u0a, u0b);
        unpack8(*(const GAS v4u*)(F.GC + (size_t)row * D + ch), ga, gb);
        if (tis >= 1) unpack8(*(const GAS v4u*)(F.U + (size_t)(row - 1) * D + ch), u1a, u1b);
        else if (smp) { const float* s = F.state_conv + ((size_t)b * 2 + 1) * D + ch; u1a = *(const GAS f32x4*)s; u1b = *(const GAS f32x4*)(s + 4); }
        else { u1a = (f32x4){0.f, 0.f, 0.f, 0.f}; u1b = u1a; }
        if (tis >= 2) unpack8(*(const GAS v4u*)(F.U + (size_t)(row - 2) * D + ch), u2a, u2b);
        else if (smp) { const float* s = F.state_conv + ((size_t)b * 2 + tis) * D + ch; u2a = *(const GAS f32x4*)s; u2b = *(const GAS f32x4*)(s + 4); }
        else { u2a = (f32x4){0.f, 0.f, 0.f, 0.f}; u2b = u2a; }
        const f32x4 c0a = *(const GAS f32x4*)(F.conv_w + ch), c0b = *(const GAS f32x4*)(F.conv_w + ch + 4);
        const f32x4 c1a = *(const GAS f32x4*)(F.conv_w + D + ch), c1b = *(const GAS f32x4*)(F.conv_w + D + ch + 4);
        const f32x4 c2a = *(const GAS f32x4*)(F.conv_w + 2 * D + ch), c2b = *(const GAS f32x4*)(F.conv_w + 2 * D + ch + 4);
        const f32x4 ya = ga * (c0a * u2a + c1a * u1a + c2a * u0a), yb = gb * (c0b * u2b + c1b * u1b + c2b * u0b);
        *(GAS v4u*)(YC + (size_t)row * D + ch) = pack8(ya, yb);
    }
}

typedef _Float16 h8 __attribute__((ext_vector_type(8)));
typedef _Float16 h4 __attribute__((ext_vector_type(4)));
#define MFMA16(a, b, c) __builtin_amdgcn_mfma_f32_16x16x32_f16((a), (b), (c), 0, 0, 0)
#define LH(p) ((LAS _Float16*)(p))
constexpr int SCAN_WUPT = 0, SCAN_AUPT = 8192, SCAN_CONST = 16384, SCAN_PREV = 19968  , SCAN_SLOT0 = 24576;
constexpr int S_KT = 0, S_RT = 2048, S_BK = 4096, S_VT = 8192, S_ABR = 10240, S_AKK = 11264, S_MINV = 11776, S_RHO = 12288, S_C1 = 12544, S_Y = 12800, SLOT_BYTES = 16896;
constexpr int S_TW = S_KT, S_XA = S_RT, S_BT = S_Y, S_KHT = S_Y + 2048;
static_assert(SCAN_SLOT0 + 8 * SLOT_BYTES <= LDSCTL_OFF, "scan LDS");
#define DPP_F(v, ctrl) __builtin_bit_cast(float, __builtin_amdgcn_update_dpp(0, __builtin_bit_cast(int, (v)), (ctrl), 0xF, 0xF, true))
__device__ __forceinline__ float red16(float v) {
    v += DPP_F(v, 0xB1); v += DPP_F(v, 0x4E); v += DPP_F(v, 0x141); v += DPP_F(v, 0x140); return v;
}
__device__ __forceinline__ h4 cvt4(const f32x4 x) { return __builtin_convertvector(x, h4); }
__device__ __forceinline__ h8 cat44(const h4 a, const h4 b) { return (h8){a[0], a[1], a[2], a[3], b[0], b[1], b[2], b[3]}; }
__device__ __forceinline__ h8 frag4h(const h4 a) { const _Float16 z = (_Float16)0.f; return (h8){a[0], a[1], a[2], a[3], z, z, z, z}; }
__device__ __forceinline__ h8 frag4(const f32x4 x) { return frag4h(cvt4(x)); }
__device__ __forceinline__ float fast_tanh(float x) { return 1.0f - 2.0f * __builtin_amdgcn_rcpf(1.0f + __expf(2.0f * x)); }

__device__ __forceinline__ void scan_load_head(Frame& F, LAS unsigned char* SC, int h) {
    for (int i = F.tid; i < 4096; i += NWAVES * 64) { const int c = i >> 6, r = i & 63;
        LH(SC + SCAN_WUPT)[i] = (_Float16)F.w_up[r * D + h * 64 + c]; LH(SC + SCAN_AUPT)[i] = (_Float16)F.a_up[r * D + h * 64 + c]; }
    LAS float* CN = (LAS float*)(SC + SCAN_CONST);
    for (int i = F.tid; i < 13 * 64; i += NWAVES * 64) { const int a = i >> 6, c = i & 63, col = h * 64 + c; float v;
        switch (a) { case 0: v = F.mu[col]; break; case 1: v = F.mu[1024 + col]; break; case 2: v = F.mu[2048 + col]; break; case 3: v = F.mu[3200 + col]; break;
                     case 4: v = F.mu[3072 + c]; break; case 5: v = F.mu[3136 + c]; break; case 6: v = F.w0[col]; break; case 7: v = F.a0[col]; break;
                     case 8: v = F.k_k[col]; break; case 9: v = F.k_a[col]; break; case 10: v = F.r_k[col]; break; case 11: v = F.ln_w[col]; break; default: v = F.ln_b[col]; break; }
        CN[i] = v; }
}

__device__ __forceinline__ void unpack4(const u32x2 w, float (&o)[4]) { o[0] = bflo(w.x); o[1] = bfhi(w.x); o[2] = bflo(w.y); o[3] = bfhi(w.y); }
__device__ __forceinline__ void produce_chunk(Frame& F, LAS unsigned char* SC, LAS unsigned char* slot, int h, int g0, int T0, int nvalid, int plast_row,
                                              const LAS float* prev_in, LAS float* prev_out, float (&vv)[4][4], float (&zg)[4][4], float (&bon)[4]) {
    const int lane = F.lane, c16 = lane & 15, q = lane >> 4, c4 = 4 * c16;
    const LAS float* CN = (const LAS float*)(SC + SCAN_CONST);
    const int trow0 = T0 + 4 * q;
    const size_t row0 = (size_t)(g0 + trow0);
    const bool first = trow0 == 0, has_prev = !first || plast_row >= 0;
    const size_t prow = first ? (size_t)(plast_row >= 0 ? plast_row : 0) : row0 - 1;
    const bool valid = 4 * q < nvalid;
    float xr[4][4], xk[4][4];
    float n2[4] = {0.f, 0.f, 0.f, 0.f}, bs[4] = {0.f, 0.f, 0.f, 0.f};
    {
        float pr[4], pk[4], pv[4], pz[4], pw[4], pa[4];
        if (q == 0 && prev_in) {
#pragma unroll
            for (int ct = 0; ct < 4; ++ct) { pr[ct] = prev_in[c4 + ct]; pk[ct] = prev_in[64 + c4 + ct]; pv[ct] = prev_in[128 + c4 + ct]; pz[ct] = prev_in[192 + c4 + ct]; pw[ct] = prev_in[256 + c4 + ct]; pa[ct] = prev_in[320 + c4 + ct]; }
        } else if (has_prev) { const size_t o = prow * D + h * 64 + c4;
            unpack4(*(const GAS u32x2*)(F.R + o), pr); unpack4(*(const GAS u32x2*)(F.K + o), pk); unpack4(*(const GAS u32x2*)(F.V + o), pv); unpack4(*(const GAS u32x2*)(F.ZR + o), pz);
            unpack4(*(const GAS u32x2*)(F.WA + prow * 256 + c4), pw); unpack4(*(const GAS u32x2*)(F.WA + prow * 256 + 64 + c4), pa);
        } else {
#pragma unroll
            for (int ct = 0; ct < 4; ++ct) { pr[ct] = 0.f; pk[ct] = 0.f; pv[ct] = 0.f; pz[ct] = 0.f; pw[ct] = 0.f; pa[ct] = 0.f; }
        }
        const f32x4 mr = *(const LAS f32x4*)(CN + c4), mk = *(const LAS f32x4*)(CN + 64 + c4), mv = *(const LAS f32x4*)(CN + 128 + c4), mz = *(const LAS f32x4*)(CN + 192 + c4),
                    mw = *(const LAS f32x4*)(CN + 256 + c4), ma = *(const LAS f32x4*)(CN + 320 + c4), kkc = *(const LAS f32x4*)(CN + 8 * 64 + c4);
#pragma unroll
        for (int reg = 0; reg < 4; ++reg) {
            const size_t ro = (row0 + reg) * D + h * 64 + c4, wo = (row0 + reg) * 256 + c4;
            float r[4], k[4], v[4], z[4], wd[4], ad[4];
            unpack4(*(const GAS u32x2*)(F.R + ro), r); unpack4(*(const GAS u32x2*)(F.K + ro), k); unpack4(*(const GAS u32x2*)(F.V + ro), v); unpack4(*(const GAS u32x2*)(F.ZR + ro), z);
            unpack4(*(const GAS u32x2*)(F.WA + wo), wd); unpack4(*(const GAS u32x2*)(F.WA + wo + 64), ad);
            f32x4 tw, xa;
#pragma unroll
            for (int ct = 0; ct < 4; ++ct) {
                xr[ct][reg] = r[ct] + (pr[ct] - r[ct]) * mr[ct]; const float xk_ = k[ct] + (pk[ct] - k[ct]) * mk[ct]; xk[ct][reg] = xk_; n2[reg] += (xk_ * kkc[ct]) * (xk_ * kkc[ct]);
                vv[ct][reg] = v[ct] + (pv[ct] - v[ct]) * mv[ct]; const float xz = z[ct] + (pz[ct] - z[ct]) * mz[ct]; zg[ct][reg] = xz * sigmoidf_(xz);
                tw[ct] = fast_tanh(wd[ct] + (pw[ct] - wd[ct]) * mw[ct]); xa[ct] = ad[ct] + (pa[ct] - ad[ct]) * ma[ct];
                pr[ct] = r[ct]; pk[ct] = k[ct]; pv[ct] = v[ct]; pz[ct] = z[ct]; pw[ct] = wd[ct]; pa[ct] = ad[ct];
            }
            *(LAS h4*)(LH(slot + S_TW) + (4 * q + reg) * 64 + c4) = cvt4(tw); *(LAS h4*)(LH(slot + S_XA) + (4 * q + reg) * 64 + c4) = cvt4(xa);
        }
        if (prev_out && q == 3) {
#pragma unroll
            for (int ct = 0; ct < 4; ++ct) { prev_out[c4 + ct] = pr[ct]; prev_out[64 + c4 + ct] = pk[ct]; prev_out[128 + c4 + ct] = pv[ct]; prev_out[192 + c4 + ct] = pz[ct]; prev_out[256 + c4 + ct] = pw[ct]; prev_out[320 + c4 + ct] = pa[ct]; }
        }
    }
    float lg[4][4], av[4][4];
    {
        const h8 ta0 = *(const LAS h8*)(LH(slot + S_TW) + c16 * 64 + q * 8), ta1 = *(const LAS h8*)(LH(slot + S_TW) + c16 * 64 + 32 + q * 8);
        const h8 xa0 = *(const LAS h8*)(LH(slot + S_XA) + c16 * 64 + q * 8), xa1 = *(const LAS h8*)(LH(slot + S_XA) + c16 * 64 + 32 + q * 8);
        const f32x4 w0c = *(const LAS f32x4*)(CN + 6 * 64 + c4), a0c = *(const LAS f32x4*)(CN + 7 * 64 + c4), kac = *(const LAS f32x4*)(CN + 9 * 64 + c4), rkc = *(const LAS f32x4*)(CN + 10 * 64 + c4);
#pragma unroll
        for (int ct = 0; ct < 4; ++ct) {
            const LAS _Float16* wu = LH(SC + SCAN_WUPT) + (c4 + ct) * 64 + q * 8; const LAS _Float16* au = LH(SC + SCAN_AUPT) + (c4 + ct) * 64 + q * 8;
            f32x4 wl = (f32x4){0.f, 0.f, 0.f, 0.f}, al = wl;
            wl = MFMA16(ta0, *(const LAS h8*)wu, wl); wl = MFMA16(ta1, *(const LAS h8*)(wu + 32), wl);
            al = MFMA16(xa0, *(const LAS h8*)au, al); al = MFMA16(xa1, *(const LAS h8*)(au + 32), al);
#pragma unroll
            for (int reg = 0; reg < 4; ++reg) {
                lg[ct][reg] = valid ? -0.6065306597126334f * sigmoidf_(w0c[ct] + wl[reg]) : 0.f;
                const float a = sigmoidf_(a0c[ct] + al[reg]); av[ct][reg] = a;
                bs[reg] += xr[ct][reg] * (xk[ct][reg] * (1.0f + (a - 1.0f) * kac[ct])) * rkc[ct];
            }
        }
    }
    float inv[4];
#pragma unroll
    for (int reg = 0; reg < 4; ++reg) { inv[reg] = valid ? 1.0f / fmaxf(sqrtf(red16(n2[reg])), 1e-12f) : 0.f; bon[reg] = red16(bs[reg]); }
    if (!valid) {
#pragma unroll
        for (int ct = 0; ct < 4; ++ct)
#pragma unroll
            for (int reg = 0; reg < 4; ++reg) { xk[ct][reg] = 0.f; vv[ct][reg] = 0.f; xr[ct][reg] = 0.f; }
    }
    {
    const f32x4 kkc = *(const LAS f32x4*)(CN + 8 * 64 + c4), kac = *(const LAS f32x4*)(CN + 9 * 64 + c4);
#pragma unroll
    for (int ct = 0; ct < 4; ++ct) {
        float Lin[4]; Lin[0] = lg[ct][0]; Lin[1] = Lin[0] + lg[ct][1]; Lin[2] = Lin[1] + lg[ct][2]; Lin[3] = Lin[2] + lg[ct][3];
        const float tot = Lin[3], t1 = __shfl(tot, lane - 16), t2 = __shfl(tot, lane - 32), t3 = __shfl(tot, lane - 48);
        const float off = (q >= 1 ? t1 : 0.f) + (q >= 2 ? t2 : 0.f) + (q >= 3 ? t3 : 0.f);
#pragma unroll
        for (int reg = 0; reg < 4; ++reg) Lin[reg] += off;
        const float Lref = __shfl(Lin[3], c16 + 16), L15 = __shfl(Lin[3], c16 + 48);
        const int pos = 32 * (ct >> 1) + 8 * (c16 >> 2) + 4 * (ct & 1) + (c16 & 3);
        f32x4 btv, khv;
#pragma unroll
        for (int reg = 0; reg < 4; ++reg) {
            const float e1 = __expf(Lin[reg] - lg[ct][reg] - Lref), e2 = __expf(Lin[reg] - Lref), e3 = __expf(Lref - Lin[reg]);
            const float a = av[ct][reg], k = xk[ct][reg], kk = k * kkc[ct] * inv[reg], kh = k * (1.0f + (a - 1.0f) * kac[ct]);
            const float kt = kk * e1, rt = xr[ct][reg] * e2, bt = kk * a * e3, kht = kh * e3;
            const int o = (4 * q + reg) * 64 + pos;
            LH(slot + S_KT)[o] = (_Float16)kt; LH(slot + S_RT)[o] = (_Float16)rt; LH(slot + S_BT)[o] = (_Float16)bt; LH(slot + S_KHT)[o] = (_Float16)kht;
            btv[reg] = -bt; khv[reg] = kht;
        }
        *(LAS h8*)(LH(slot + S_BK) + ct * 512 + c16 * 32 + q * 8) = cat44(cvt4(btv), cvt4(khv));
        { f32x4 v4; v4[0] = vv[ct][0]; v4[1] = vv[ct][1]; v4[2] = vv[ct][2]; v4[3] = vv[ct][3]; *(LAS h4*)(LH(slot + S_VT) + (16 * ct + c16) * 16 + 4 * q) = cvt4(v4); }
        if (q == 0) { const int o = (c16 >> 2) * 16 + ct * 4 + (c16 & 3); ((LAS float*)(slot + S_RHO))[o] = __expf(Lref); ((LAS float*)(slot + S_C1))[o] = __expf(L15 - Lref); }
    }
    }
    const h8 kt0 = *(const LAS h8*)(LH(slot + S_KT) + c16 * 64 + q * 8), kt1 = *(const LAS h8*)(LH(slot + S_KT) + c16 * 64 + 32 + q * 8);
    const h8 rt0 = *(const LAS h8*)(LH(slot + S_RT) + c16 * 64 + q * 8), rt1 = *(const LAS h8*)(LH(slot + S_RT) + c16 * 64 + 32 + q * 8);
    const h8 bt0 = *(const LAS h8*)(LH(slot + S_BT) + c16 * 64 + q * 8), bt1 = *(const LAS h8*)(LH(slot + S_BT) + c16 * 64 + 32 + q * 8);
    const h8 kh0 = *(const LAS h8*)(LH(slot + S_KHT) + c16 * 64 + q * 8), kh1 = *(const LAS h8*)(LH(slot + S_KHT) + c16 * 64 + 32 + q * 8);
    const f32x4 z4 = (f32x4){0.f, 0.f, 0.f, 0.f};
    f32x4 Akk = MFMA16(kh0, kt0, z4); Akk = MFMA16(kh1, kt1, Akk);
    f32x4 Abr = MFMA16(bt0, rt0, z4); Abr = MFMA16(bt1, rt1, Abr);
    f32x4 Akr = MFMA16(kh0, rt0, z4); Akr = MFMA16(kh1, rt1, Akr);
    f32x4 N = MFMA16(bt0, kt0, z4); N = MFMA16(bt1, kt1, N);
    f32x4 NT = MFMA16(kt0, bt0, z4); NT = MFMA16(kt1, bt1, NT);
    f32x4 I4;
#pragma unroll
    for (int reg = 0; reg < 4; ++reg) { const int rw = 4 * q + reg;
        Akk[reg] = rw < c16 ? Akk[reg] : 0.f; Abr[reg] = rw <= c16 ? -Abr[reg] : 0.f; Akr[reg] = rw <= c16 ? Akr[reg] : 0.f;
        N[reg] = rw < c16 ? N[reg] : 0.f; NT[reg] = c16 < rw ? NT[reg] : 0.f; I4[reg] = rw == c16 ? 1.f : 0.f; }
    *(LAS h4*)(LH(slot + S_AKK) + c16 * 16 + 4 * q) = cvt4(Akk);
    *(LAS h8*)(LH(slot + S_ABR) + c16 * 32 + q * 8) = cat44(cvt4(Abr), cvt4(Akr));
    const h8 fN = frag4(N), fNT = frag4(NT);
    const f32x4 T1 = I4 - N, T1T = I4 - NT;
    const h8 fT1T = frag4(T1T);
    const f32x4 N2 = MFMA16(fNT, fN, z4), N2T = MFMA16(fN, fNT, z4);
    const h8 fN2 = frag4(N2), fN2T = frag4(N2T);
    const f32x4 T2 = MFMA16(fT1T, fN2, T1), T2T = MFMA16(fN2, fT1T, T1T);
    const f32x4 N4 = MFMA16(fN2T, fN2, z4), N4T = MFMA16(fN2, fN2T, z4);
    const h8 fN4 = frag4(N4), fN4T = frag4(N4T), fT2T = frag4(T2T);
    const f32x4 T3 = MFMA16(fT2T, fN4, T2), T3T = MFMA16(fN4, fT2T, T2T);
    const f32x4 N8 = MFMA16(fN4T, fN4, z4);
    const f32x4 Minv = MFMA16(frag4(T3T), frag4(N8), T3);
    *(LAS h4*)(LH(slot + S_MINV) + c16 * 16 + 4 * q) = cvt4(Minv);
}

struct ConsEarly { f32x4 rho[4]; h4 vt, akk; h8 kt0, kt1; };
__device__ __forceinline__ void consume_early(ConsEarly& e, const LAS unsigned char* slot, int vb, int lane) {
    const int vl = lane & 15, q = lane >> 4;
    const LAS float* RHOq = (const LAS float*)(slot + S_RHO) + q * 16;
#pragma unroll
    for (int kb = 0; kb < 4; ++kb) e.rho[kb] = *(const LAS f32x4*)(RHOq + 4 * kb);
    e.vt = *(const LAS h4*)(LH(slot + S_VT) + (vb + vl) * 16 + 4 * q);
    e.akk = *(const LAS h4*)(LH(slot + S_AKK) + vl * 16 + 4 * q);
    e.kt0 = *(const LAS h8*)(LH(slot + S_KT) + vl * 64 + q * 8); e.kt1 = *(const LAS h8*)(LH(slot + S_KT) + vl * 64 + 32 + q * 8);
}
__device__ __forceinline__ void consume_chunk(LAS unsigned char* slot, const ConsEarly& e, int vb, f32x4 (&zt)[4], int lane) {
    const int vl = lane & 15, q = lane >> 4;
    const LAS float* C1q = (const LAS float*)(slot + S_C1) + q * 16;
    const h8 rt0 = *(const LAS h8*)(LH(slot + S_RT) + vl * 64 + q * 8), rt1 = *(const LAS h8*)(LH(slot + S_RT) + vl * 64 + 32 + q * 8);
    const h4 minv = *(const LAS h4*)(LH(slot + S_MINV) + vl * 16 + 4 * q);
    const h8 abr = *(const LAS h8*)(LH(slot + S_ABR) + vl * 32 + q * 8);
    h8 bk[4]; f32x4 c1[4];
#pragma unroll
    for (int kb = 0; kb < 4; ++kb) { bk[kb] = *(const LAS h8*)(LH(slot + S_BK) + kb * 512 + vl * 32 + q * 8); c1[kb] = *(const LAS f32x4*)(C1q + 4 * kb); }
    f32x4 zr[4];
#pragma unroll
    for (int kb = 0; kb < 4; ++kb) zr[kb] = zt[kb] * e.rho[kb];
    const h8 zq0 = cat44(cvt4(zr[0]), cvt4(zr[1])), zq1 = cat44(cvt4(zr[2]), cvt4(zr[3]));
    const f32x4 z4 = (f32x4){0.f, 0.f, 0.f, 0.f};
    f32x4 X = MFMA16(e.kt0, zq0, z4); X = MFMA16(e.kt1, zq1, X);
    X = MFMA16(frag4h(e.akk), frag4h(e.vt), X);
    f32x4 Y = MFMA16(rt0, zq0, z4); Y = MFMA16(rt1, zq1, Y);
    const f32x4 UT = MFMA16(frag4h(minv), frag4(X), z4);
    const h8 uv = cat44(cvt4(UT), e.vt);
#pragma unroll
    for (int kb = 0; kb < 4; ++kb) { const f32x4 zn = MFMA16(bk[kb], uv, zr[kb]); zt[kb] = zn * c1[kb]; }
    Y = MFMA16(abr, uv, Y);
    LAS float* YB = (LAS float*)(slot + S_Y);
#pragma unroll
    for (int reg = 0; reg < 4; ++reg) YB[(4 * q + reg) * 64 + vb + vl] = Y[reg];
}

__device__ __forceinline__ void post_chunk(Frame& F, LAS unsigned char* SC, LAS unsigned char* slot, int h, size_t row0, int nvalid,
                                           const float (&vv)[4][4], const float (&zg)[4][4], const float (&bon)[4], bf16* YR) {
    const int lane = F.lane, c16 = lane & 15, q = lane >> 4;
    const LAS float* CN = (const LAS float*)(SC + SCAN_CONST); const LAS float* YB = (const LAS float*)(slot + S_Y);
    const bool valid = 4 * q < nvalid;
    float y[4][4];
#pragma unroll
    for (int ct = 0; ct < 4; ++ct)
#pragma unroll
        for (int reg = 0; reg < 4; ++reg) y[ct][reg] = YB[(4 * q + reg) * 64 + 16 * ct + c16];
#pragma unroll
    for (int reg = 0; reg < 4; ++reg) {
        const float mean = red16((y[0][reg] + y[1][reg]) + (y[2][reg] + y[3][reg])) * (1.f / 64.f);
        float d0 = y[0][reg] - mean, d1 = y[1][reg] - mean, d2 = y[2][reg] - mean, d3 = y[3][reg] - mean;
        const float var = red16((d0 * d0 + d1 * d1) + (d2 * d2 + d3 * d3)) * (1.f / 64.f), rstd = 1.0f / sqrtf(var + GN_EPS);
        y[0][reg] = d0 * rstd; y[1][reg] = d1 * rstd; y[2][reg] = d2 * rstd; y[3][reg] = d3 * rstd;
    }
    if (valid) {
        const f32x4 lw = *(const LAS f32x4*)(CN + 11 * 64 + 4 * c16), lb = *(const LAS f32x4*)(CN + 12 * 64 + 4 * c16);
#pragma unroll
        for (int reg = 0; reg < 4; ++reg) { float o[4];
#pragma unroll
            for (int ct = 0; ct < 4; ++ct) o[ct] = (y[ct][reg] * lw[ct] + lb[ct] + bon[reg] * vv[ct][reg]) * zg[ct][reg];
            u32x2 w; w.x = cvt_pk_bf16(o[0], o[1]); w.y = cvt_pk_bf16(o[2], o[3]);
            *(GAS u32x2*)(YR + (row0 + reg) * D + h * 64 + 4 * c16) = w; }
    }
}

template <int mode> __device__ __forceinline__ void scan_prompt_unit(Frame& F, int b, int h, bf16* YR) {
    LAS unsigned char* SC = F.lds + RING_OFF; const int w = F.wave, lane = F.lane;
    scan_load_head(F, SC, h);
    __syncthreads();
    f32x4 zt[4];
#pragma unroll
    for (int kb = 0; kb < 4; ++kb) zt[kb] = (f32x4){0.f, 0.f, 0.f, 0.f};
    LAS unsigned char* myslot = SC + SCAN_SLOT0 + w * SLOT_BYTES;
    const int g0 = b * SEQ;
    for (int s = 0; s < SEQ / 128; ++s) {
        const int T0 = (8 * s + w) * 16;
        float vv[4][4], zg[4][4], bon[4];
        LAS float* PV = (LAS float*)(SC + SCAN_PREV);
        if (!(mode & 4)) produce_chunk(F, SC, myslot, h, g0, T0, 16, -1, (w == 0 && s > 0) ? PV + ((s - 1) & 1) * 384 : nullptr, w == 7 ? PV + (s & 1) * 384 : nullptr, vv, zg, bon);
        __syncthreads();
        if (w < 4 && !(mode & 1)) {
#pragma unroll 1
            for (int i = 0; i < 8; i += 2) {
                ConsEarly ea, eb; consume_early(ea, SC + SCAN_SLOT0 + i * SLOT_BYTES, 16 * w, lane); consume_early(eb, SC + SCAN_SLOT0 + (i + 1) * SLOT_BYTES, 16 * w, lane);
                consume_chunk(SC + SCAN_SLOT0 + i * SLOT_BYTES, ea, 16 * w, zt, lane);
                consume_chunk(SC + SCAN_SLOT0 + (i + 1) * SLOT_BYTES, eb, 16 * w, zt, lane);
            }
        }
        __syncthreads();
        if (!(mode & 2)) post_chunk(F, SC, myslot, h, (size_t)(g0 + T0 + 4 * (lane >> 4)), 16, vv, zg, bon, YR);
    }
    if (w < 4) { float* So = F.out + O_NRP + (size_t)(b * NH + h) * 4096; const int vl = lane & 15, q = lane >> 4;
#pragma unroll
        for (int reg = 0; reg < 4; ++reg) *(GAS f32x4*)(So + (4 * vl + w) * 64 + 16 * q + 4 * reg) = (f32x4){zt[0][reg], zt[1][reg], zt[2][reg], zt[3][reg]}; }
    __syncthreads();
}
__device__ __forceinline__ void scan_sample_units(Frame& F, int h, int bs, int nb, bf16* YR) {
    LAS unsigned char* SC = F.lds + RING_OFF; const int w = F.wave, lane = F.lane, vl = lane & 15, q = lane >> 4;
    scan_load_head(F, SC, h);
    __syncthreads();
    LAS unsigned char* myslot = SC + SCAN_SLOT0 + w * SLOT_BYTES;
    for (int bi = w; bi < nb; bi += NWAVES) {
        const int b = bs + bi, g0 = NPR + 4 * b;
        float vv[4][4], zg[4][4], bon[4];
        produce_chunk(F, SC, myslot, h, g0, 0, 4, NROW + b, nullptr, nullptr, vv, zg, bon);
        const float* S0 = F.state_rwkv + (size_t)(b * NH + h) * 4096; float* So = F.out + O_NRS + (size_t)(b * NH + h) * 4096;
#pragma unroll 1
        for (int cw = 0; cw < 4; ++cw) {
            f32x4 zt[4];
#pragma unroll
            for (int reg = 0; reg < 4; ++reg) { const f32x4 t = *(const GAS f32x4*)(S0 + (4 * vl + cw) * 64 + 16 * q + 4 * reg); zt[0][reg] = t[0]; zt[1][reg] = t[1]; zt[2][reg] = t[2]; zt[3][reg] = t[3]; }
            ConsEarly ea; consume_early(ea, myslot, 16 * cw, lane);
            consume_chunk(myslot, ea, 16 * cw, zt, lane);
#pragma unroll
            for (int reg = 0; reg < 4; ++reg) *(GAS f32x4*)(So + (4 * vl + cw) * 64 + 16 * q + 4 * reg) = (f32x4){zt[0][reg], zt[1][reg], zt[2][reg], zt[3][reg]};
        }
        post_chunk(F, SC, myslot, h, (size_t)(g0 + 4 * q), 4, vv, zg, bon, YR);
    }
    __syncthreads();
}
template <int mode> __device__ __forceinline__ void p2_scan(Frame& F, bf16* YR) {
    if (F.G == 256) {
        if (blockIdx.x < 128) scan_prompt_unit<mode>(F, blockIdx.x >> 4, blockIdx.x & 15, YR);
        else { const int sb = blockIdx.x - 128; scan_sample_units(F, sb & 15, (sb >> 4) * 16, 16, YR); }
    } else {
        for (int u = blockIdx.x; u < 128 + 128; u += F.G) {
            if (u < 128) scan_prompt_unit<mode>(F, u >> 4, u & 15, YR); else { const int sb = u - 128; scan_sample_units(F, sb & 15, (sb >> 4) * 16, 16, YR); }
        }
    }
}
__device__ __forceinline__ void p3_final_norm(Frame& F) {
    const int gw = blockIdx.x * NWAVES + F.wave, NGW = F.G * NWAVES;
    for (int m = gw; m < NROW; m += NGW) {
        GAS f32x4* xr = (GAS f32x4*)(F.out + O_Y + (size_t)m * D) + F.lane; const GAS f32x4* gr = (const GAS f32x4*)F.final_g + F.lane;
        const GAS f32x4* st = (const GAS f32x4*)(F.STATS + (size_t)m * 16);
        const f32x4 s0 = st[0], s1 = st[1], s2 = st[2], s3 = st[3];
        const float ss = ((s0.x + s0.y) + (s0.z + s0.w)) + ((s1.x + s1.y) + (s1.z + s1.w)) + ((s2.x + s2.y) + (s2.z + s2.w)) + ((s3.x + s3.y) + (s3.z + s3.w));
        const float rs = 1.0f / sqrtf(ss * (1.f / D) + RMS_EPS);
#pragma unroll
        for (int j = 0; j < 4; ++j) { const f32x4 v = xr[64 * j]; xr[64 * j] = (v * rs) * gr[64 * j]; }
    }
}


__device__ __forceinline__ void sub_barrier(Frame& F, int word, unsigned n, unsigned code) {
    asm volatile("s_waitcnt vmcnt(0)" ::: "memory");
    __syncthreads();
    if (F.tid == 0) {
        gu32* cnt = F.ctl + word;
        __builtin_amdgcn_fence(__ATOMIC_RELEASE, "agent");
        asm volatile("s_waitcnt vmcnt(0)" ::: "memory");
        (void)__hip_atomic_fetch_add(cnt, 1u, RLX_AGENT);
        unsigned sp = 0;
        while (__hip_atomic_load(cnt, RLX_AGENT) < n) { __builtin_amdgcn_s_sleep(2);
            if ((++sp & 1023u) == 0u && (sp > (1u << 22) || __hip_atomic_load(F.ctl + CW_TMO, RLX_AGENT) != 0u)) { __hip_atomic_store(F.ctl + CW_TMO, code, RLX_AGENT); break; } }
        __builtin_amdgcn_fence(__ATOMIC_ACQUIRE, "agent");
        asm volatile("s_waitcnt vmcnt(0)" ::: "memory");
    }
    __syncthreads();
}
struct SampleOrder {
    int u;
    __device__ __forceinline__ bool next(int i, pg8::Unit& un) const { if (i != 0) return false; un.pm = 64 + (u >> 2); un.pn = u & 3; return true; }
    __device__ __forceinline__ void a_ready(const pg8::Unit&) const {}
    __device__ __forceinline__ void done(const pg8::Unit&) const {}
};

struct Args { const float* in[22]; float* out; unsigned char* ws; int ph_lo, ph_hi; };
__global__ void __launch_bounds__(NWAVES * 64, 2) mk_fwd(Args args) {
    extern __shared__ __attribute__((aligned(16))) unsigned char lds[];
    Frame F;
    F.lds = (LAS unsigned char*)lds;
    F.MISC = (volatile LAS unsigned*)(F.lds + MISC_OFF);
    F.tid = threadIdx.x; F.lane = F.tid & 63; F.wave = __builtin_amdgcn_readfirstlane(F.tid >> 6);
    F.G = gridDim.x;
    unsigned char* ws = args.ws;
    F.ctl = (gu32*)(ws + WS_CTL);
    F.x_prompt = args.in[0]; F.x_sample = args.in[1]; F.state_conv = args.in[2]; F.state_shift = args.in[3]; F.state_rwkv = args.in[4]; F.norm_g = args.in[5]; F.w_in = args.in[6];
    F.conv_w = args.in[7]; F.mu = args.in[8]; F.w0 = args.in[9]; F.w_up = args.in[10]; F.a0 = args.in[11]; F.a_up = args.in[12]; F.k_k = args.in[13]; F.k_a = args.in[14]; F.r_k = args.in[15];
    F.ln_w = args.in[16]; F.ln_b = args.in[17]; F.w_out_c = args.in[18]; F.w_out_r = args.in[19]; F.w_o = args.in[20]; F.final_g = args.in[21];
    F.out = args.out;
    F.Wt_in = (bf16*)(args.out + O_NRS); F.SGCp = (bf16*)(args.out + O_Y); F.SGRp = F.SGCp + (size_t)NPR * D;
    F.Wt_oc = (bf16*)(ws + WS_WOC); F.Wt_or = (bf16*)(ws + WS_WOR); F.Wt_o = (bf16*)(ws + WS_WO);
    F.STATS = (float*)(ws + WS_STATS); F.SGCs = (bf16*)(ws + WS_SGS); F.SGRs = F.SGCs + (size_t)NSR * D;
    F.H = (bf16*)(ws + WS_H); F.U = (bf16*)(ws + WS_U); F.GC = (bf16*)(ws + WS_GC); F.T1 = (float*)(ws + WS_U);
    F.R = (bf16*)(ws + WS_R); F.K = (bf16*)(ws + WS_K); F.V = (bf16*)(ws + WS_V); F.ZR = (bf16*)(ws + WS_ZR); F.WA = (bf16*)(ws + WS_WA);
    for (int u = F.tid; u < (LDS_BYTES - LDSCTL_OFF) / 4; u += NWAVES * 64) ((LAS unsigned*)(F.lds + LDSCTL_OFF))[u] = 0u;
    __syncthreads();
    XcdBarrier bar; bar.bar = (unsigned*)(F.ctl + CW_BAR); bar.x = 0; bar.st = nullptr;
    if (N_LAUNCHES == 1) bar = xcd_barrier_post((unsigned*)(F.ctl + CW_BAR), F.MISC + 8);
#define GRID_BAR() do { if (N_LAUNCHES == 1) xcd_barrier(bar); } while (0)
    const int lo = args.ph_lo, hi = args.ph_hi;
#define IN(k) (lo <= (k) && (k) < hi)
#define BOTH(k) (IN(k) && IN((k) + 1))

    if (IN(0)) { p0_prologue(F); if (PROBE_DUP & 1) p0_prologue(F); if (BOTH(0)) GRID_BAR(); }

    if (IN(1)) {
        pg8::Gemm g{F.H, F.Wt_in, NROWP, NT_IN * 256, D}; P1Order S{F.G, (int)blockIdx.x};
        EpiP1 E{F.U, F.GC, F.R, F.WA, F.SGCp, F.SGCs, F.out + O_NCP, F.out + O_NCS};
        pg8::gemm_phase<EpiP1, P1Order, true, true>(F.lds + RING_OFF, g, S, E);
        if (PROBE_DUP & 2) pg8::gemm_phase<EpiP1, P1Order, true, true>(F.lds + RING_OFF, g, S, E);
        if (BOTH(1)) GRID_BAR();
    }

    if (IN(2)) {
        if (blockIdx.x < 128) scan_prompt_unit<0>(F, blockIdx.x >> 4, blockIdx.x & 15, F.R);
        else {
            const int hid = blockIdx.x - 128;
            p2_convmix(F, hid, 128);
            scan_sample_units(F, hid & 15, (hid >> 4) * 16, 16, F.R);
            sub_barrier(F, CW_HB0, 128, 0x510u);
            if (hid < 8) {
                const SampleOrder S{hid};
                { pg8::Gemm g{F.H, F.Wt_oc, NROW, D, D}; EpiT1 E{F.T1, F.SGCp, F.SGCs}; pg8::gemm_phase<EpiT1, SampleOrder, false, true>(F.lds + RING_OFF, g, S, E); }
                sub_barrier(F, CW_HB1, 8, 0x520u);
                { pg8::Gemm g{F.R, F.Wt_or, NROW, D, D}; EpiM E{F.T1, F.K, F.SGRp, F.SGRs}; pg8::gemm_phase<EpiM, SampleOrder, false, true>(F.lds + RING_OFF, g, S, E); }
                sub_barrier(F, CW_HB2, 8, 0x530u);
                { pg8::Gemm g{F.K, F.Wt_o, NROW, D, D}; EpiXo E{F.x_prompt, F.x_sample, F.out + O_Y, F.STATS}; pg8::gemm_phase<EpiXo, SampleOrder, false, true>(F.lds + RING_OFF, g, S, E); }
            } else {
                pg8::Gemm g{F.H, F.Wt_oc, NPR, D, D}; pg8::StaticOrder S; S.init(NPR, D, 120, hid - 8);
                EpiT1 E{F.T1, F.SGCp, F.SGCs};
                pg8::gemm_phase<EpiT1, pg8::StaticOrder, true, true>(F.lds + RING_OFF, g, S, E);
            }
        }
        if (BOTH(2)) GRID_BAR();
    }
    if (IN(3)) {
        pg8::Gemm g{F.R, F.Wt_or, NPR, D, D}; pg8::StaticOrder S; S.init(NPR, D, F.G, (int)blockIdx.x);
        EpiM E{F.T1, F.K, F.SGRp, F.SGRs};
        pg8::gemm_phase<EpiM, pg8::StaticOrder, true, true>(F.lds + RING_OFF, g, S, E);
        if (BOTH(3)) GRID_BAR();
    }
    if (IN(4)) {
        pg8::Gemm g{F.K, F.Wt_o, NPR, D, D}; pg8::StaticOrder S; S.init(NPR, D, F.G, (int)blockIdx.x);
        EpiXo E{F.x_prompt, F.x_sample, F.out + O_Y, F.STATS};
        pg8::gemm_phase<EpiXo, pg8::StaticOrder, true, true>(F.lds + RING_OFF, g, S, E);
        if (BOTH(4)) GRID_BAR();
    }
    if (IN(5)) { p3_final_norm(F); }
#undef IN
#undef BOTH
}


#if PROBE_SCAN >= 0
__global__ void __launch_bounds__(NWAVES * 64, 2) mk_probe(Args args) {
    extern __shared__ __attribute__((aligned(16))) unsigned char lds[];
    Frame F;
    F.lds = (LAS unsigned char*)lds; F.MISC = (volatile LAS unsigned*)(F.lds + MISC_OFF);
    F.tid = threadIdx.x; F.lane = F.tid & 63; F.wave = __builtin_amdgcn_readfirstlane(F.tid >> 6); F.G = gridDim.x;
    unsigned char* ws = args.ws; F.ctl = (gu32*)(ws + WS_CTL);
    F.mu = args.in[8]; F.w0 = args.in[9]; F.w_up = args.in[10]; F.a0 = args.in[11]; F.a_up = args.in[12]; F.k_k = args.in[13]; F.k_a = args.in[14]; F.r_k = args.in[15]; F.ln_w = args.in[16]; F.ln_b = args.in[17];
    F.out = args.out; F.state_rwkv = args.in[4];
    F.R = (bf16*)(ws + WS_R); F.K = (bf16*)(ws + WS_K); F.V = (bf16*)(ws + WS_V); F.ZR = (bf16*)(ws + WS_ZR); F.WA = (bf16*)(ws + WS_WA);
    if (blockIdx.x < 128) scan_prompt_unit<PROBE_SCAN>(F, blockIdx.x >> 4, blockIdx.x & 15, (bf16*)(args.out + O_NRS));
}
#endif
extern "C" void kernel_launch(void* const* d_in, const int* in_sizes, int n_in, void* d_out, int out_size, void* d_ws, size_t ws_size, hipStream_t stream) {
    static int grid = 0;
    if (grid == 0) {
        if (n_in != 22 || in_sizes[0] != NPR * D || out_size != (int)O_END || ws_size < WS_END) {
            fprintf(stderr, "kernel_launch: unexpected shapes: n_in %d in0 %d out %d ws %zu; nothing launched\n", n_in, n_in > 0 ? in_sizes[0] : -1, out_size, ws_size); grid = -1; return; }
        int dev = 0, cus = 0, per_cu = 0;
        if (hipGetDevice(&dev) != hipSuccess || hipDeviceGetAttribute(&cus, hipDeviceAttributeMultiprocessorCount, dev) != hipSuccess) { fprintf(stderr, "kernel_launch: device query failed\n"); grid = -1; return; }
        if (hipFuncSetAttribute((const void*)mk_fwd, hipFuncAttributeMaxDynamicSharedMemorySize, LDS_BYTES) != hipSuccess) { fprintf(stderr, "kernel_launch: hipFuncSetAttribute failed\n"); grid = -1; return; }
        if (hipOccupancyMaxActiveBlocksPerMultiprocessor(&per_cu, (const void*)mk_fwd, NWAVES * 64, LDS_BYTES) != hipSuccess || per_cu < 1) { fprintf(stderr, "kernel_launch: occupancy query reports %d workgroups per CU\n", per_cu); per_cu = 1; }
        (void)hipGetLastError();
        grid = cus;
        if (grid != 256) { fprintf(stderr, "kernel_launch: this kernel needs a 256-CU device (got %d)\n", grid); grid = -1; return; }
    }
    if (grid < 0) return;
    (void)hipMemsetAsync((char*)d_ws + WS_CTL, 0, CTL_ZERO_BYTES, stream);
    Args a{};
    for (int i = 0; i < 22; ++i) a.in[i] = (const float*)d_in[i];
    a.out = (float*)d_out; a.ws = (unsigned char*)d_ws;
#if PROBE_SCAN >= 0
    (void)hipFuncSetAttribute((const void*)mk_probe, hipFuncAttributeMaxDynamicSharedMemorySize, LDS_BYTES);
    a.ph_lo = 0; a.ph_hi = 2; hipLaunchKernelGGL(mk_fwd, dim3(grid), dim3(NWAVES * 64), LDS_BYTES, stream, a);
    hipLaunchKernelGGL(mk_probe, dim3(grid), dim3(NWAVES * 64), LDS_BYTES, stream, a);
    (void)hipMemsetAsync((char*)d_ws + WS_CTL, 0, CTL_ZERO_BYTES, stream);
    a.ph_lo = 2; a.ph_hi = N_PHASES; hipLaunchKernelGGL(mk_fwd, dim3(grid), dim3(NWAVES * 64), LDS_BYTES, stream, a);
    return;
#endif
    if (N_LAUNCHES == 1) { a.ph_lo = 0; a.ph_hi = N_PHASES; hipLaunchKernelGGL(mk_fwd, dim3(grid), dim3(NWAVES * 64), LDS_BYTES, stream, a); }
    else for (int li = 0; li < N_PHASES; ++li) { a.ph_lo = li; a.ph_hi = li + 1; hipLaunchKernelGGL(mk_fwd, dim3(grid), dim3(NWAVES * 64), LDS_BYTES, stream, a); }
}
```
